# Optimizing an MI355X kernel written in HIP

```python
import jax, jax.numpy as jnp
from jax import lax
import numpy as np

D_MODEL = 1024
BATCH = 8
SEQ = 2048
DEPTH = 4

CHUNK = 64
MIX_W = D_MODEL // 2
SB_HEAD_DIM = 64
SB_HEADS = MIX_W // SB_HEAD_DIM
SB_BLOCK = 128
RWKV_HEAD_DIM = 64
RWKV_HEADS = MIX_W // RWKV_HEAD_DIM
DECAY_LORA = 64
ICL_LORA = 64
GATE_LORA = 128
RWKV_IN = 3 * MIX_W + DECAY_LORA + ICL_LORA + GATE_LORA
HGRN_EXPAND = 128
HGRN_HEADS = MIX_W // HGRN_EXPAND
N_BRANCH = 3
IN_COLS = 3 * MIX_W + RWKV_IN + 4 * MIX_W + N_BRANCH * D_MODEL
D_FF = -(-(8 * D_MODEL) // (3 * 256)) * 256
ALPHA = (2 * DEPTH) ** 0.25
BETA = (8 * DEPTH) ** -0.25
LN_EPS = 1e-5
RWKV_GN_EPS = 64e-5
RMS_EPS = 1e-6

kernel_name = 'hybrid_sb_rwkv7_hgrn2_deepnorm'

F32 = jnp.float32


def _split(p, sizes):
    idx = [int(i) for i in np.cumsum(sizes)[:-1]]
    return jnp.split(p, idx, axis=-1)


def _heads(z, n):
    return z.reshape(*z.shape[:-1], n, z.shape[-1] // n)


def _layer_norm(x, g, b):
    xf = x.astype(F32)
    mu = jnp.mean(xf, -1, keepdims=True)
    var = jnp.mean(jnp.square(xf - mu), -1, keepdims=True)
    return ((xf - mu) * lax.rsqrt(var + LN_EPS)).astype(x.dtype) * g + b


def _token_shift(p):
    return jnp.pad(p[:, :-1], ((0, 0), (1, 0), (0, 0)))


def stick_breaking_attention(q, k, v):
    B, T, H, Dh = q.shape
    qh = jnp.swapaxes(q, 1, 2).astype(F32) * (Dh ** -0.5)
    kh = jnp.swapaxes(k, 1, 2).astype(F32)
    vh = jnp.swapaxes(v, 1, 2).astype(F32)
    outs = []
    for start in range(0, T, SB_BLOCK):
        end = start + SB_BLOCK
        z = jnp.einsum('bhqd,bhkd->bhqk', qh[:, :, start:end], kh[:, :, :end])
        mask = jnp.arange(end)[None, :] < jnp.arange(start, end)[:, None]
        log_keep = jnp.where(mask, jax.nn.log_sigmoid(-z), 0.0)
        log_after = lax.cumsum(log_keep, axis=3, reverse=True) - log_keep
        w = jnp.where(mask, jnp.exp(jax.nn.log_sigmoid(z) + log_after), 0.0)
        outs.append(jnp.einsum('bhqk,bhkd->bhqd', w, vh[:, :, :end]))
    o = jnp.concatenate(outs, axis=2)
    return jnp.swapaxes(o, 1, 2).reshape(B, T, H * Dh)


def _rwkv7_scan(r, decay, k, v, kk, a):
    B, T, H, N = r.shape

    def step(S, inp):
        r_t, w_t, k_t, v_t, kk_t, a_t = inp
        sa = jnp.einsum('bhvk,bhk->bhv', S, -kk_t)
        S = (S * w_t[:, :, None, :] + sa[..., None] * (kk_t * a_t)[:, :, None, :]
             + v_t[..., None] * k_t[:, :, None, :])
        return S, jnp.einsum('bhvk,bhk->bhv', S, r_t)

    xs = tuple(jnp.moveaxis(z, 1, 0) for z in (r, decay, k, v, kk, a))
    _, ys = lax.scan(step, jnp.zeros((B, H, N, N), F32), xs)
    return jnp.moveaxis(ys, 0, 1)


def rwkv7_time_mix(p, mu, w0, w_up, a0, a_up, g_up, k_k, k_a, r_k, gn_g, gn_b):
    B, T, _ = p.shape
    p = p + (_token_shift(p) - p) * mu
    r, k, v, wd, ad, gd = _split(p, [MIX_W] * 3 + [DECAY_LORA, ICL_LORA, GATE_LORA])
    w = -jax.nn.softplus(-(w0 + jnp.tanh(wd) @ w_up)) - 0.5
    decay = jnp.exp(-jnp.exp(w.astype(F32)))
    a = jax.nn.sigmoid(a0 + ad @ a_up)
    g = jax.nn.sigmoid(gd) @ g_up
    hs = lambda z: _heads(z, RWKV_HEADS).astype(F32)
    kk = hs(k * k_k)
    kk = kk * lax.rsqrt(jnp.maximum(jnp.sum(kk * kk, -1, keepdims=True), 1e-24))
    k = k * (1 + (a - 1) * k_a)
    rh, kh, vh = hs(r), hs(k), hs(v)
    y = _rwkv7_scan(rh, hs(decay), kh, vh, kk, hs(a))
    mu_y = jnp.mean(y, -1, keepdims=True)
    var_y = jnp.mean(jnp.square(y - mu_y), -1, keepdims=True)
    y = ((y - mu_y) * lax.rsqrt(var_y + RWKV_GN_EPS)).reshape(B, T, MIX_W) * gn_g + gn_b
    bonus = jnp.sum(rh * kh * _heads(r_k, RWKV_HEADS).astype(F32), -1, keepdims=True) * vh
    return (y + bonus.reshape(B, T, MIX_W)) * g


def _hgrn2_chunked(q, k, v, log_f):
    B, T, H, Dk = q.shape
    Dv = v.shape[-1]
    NC = T // CHUNK
    to_c = lambda z: z.reshape(B, NC, CHUNK, H, z.shape[-1]).transpose(1, 0, 3, 2, 4)
    tri = jnp.tril(jnp.ones((CHUNK, CHUNK), bool))

    def chunk_step(S, inp):
        qc, kc, vc, lfc = inp
        b = jnp.cumsum(lfc, axis=2)
        rel = b[:, :, :, None, :] - b[:, :, None, :, :]
        dec = jnp.exp(jnp.where(tri[:, :, None], rel, -jnp.inf))
        scores = jnp.einsum('bhtc,bhsc,bhtsc->bhts', qc, kc, dec)
        o = (jnp.einsum('bhts,bhsv->bhtv', scores, vc)
             + jnp.einsum('bhtc,bhcv->bhtv', qc * jnp.exp(b), S))
        b_last = b[:, :, -1:, :]
        S = (jnp.exp(b_last[:, :, 0, :])[..., None] * S
             + jnp.einsum('bhsc,bhsv->bhcv', kc * jnp.exp(b_last - b), vc))
        return S, o

    xs = tuple(to_c(z.astype(F32)) for z in (q, k, v, log_f))
    _, outs = lax.scan(chunk_step, jnp.zeros((B, H, Dk, Dv), F32), xs)
    return outs.transpose(1, 0, 3, 2, 4).reshape(B, T, H, Dv)


def hgrn2_mix(q, f, i, g, lb, norm_g):
    B, T, _ = q.shape
    fgate = lb + (1 - lb) * jax.nn.sigmoid(f.astype(F32))
    hs = lambda z: _heads(z, HGRN_HEADS)
    o = _hgrn2_chunked(hs(q), hs(1 - fgate), hs(jax.nn.silu(i)), hs(jnp.log(fgate)))
    o = o * lax.rsqrt(jnp.mean(jnp.square(o), -1, keepdims=True) + RMS_EPS)
    return o.reshape(B, T, MIX_W) * norm_g * jax.nn.silu(g)


def _swiglu(h, w_in, w_out):
    a, b = jnp.split(h @ w_in, 2, axis=-1)
    return (jax.nn.silu(a) * b) @ w_out


def setup_inputs(seed: int = 0) -> dict:
    key = jax.random.key(seed)
    ks = jax.random.split(key, 26)
    n = lambda k, s, sc: jax.random.normal(k, s, F32) * sc
    return {
        'x': n(ks[0], (BATCH, SEQ, D_MODEL), 1.0),
        'ln_in_g': 1.0 + n(ks[1], (D_MODEL,), 0.02),
        'ln_in_b': n(ks[2], (D_MODEL,), 0.02),
        'w_in': n(ks[3], (DEPTH, D_MODEL, IN_COLS), D_MODEL ** -0.5),
        'rwkv_mu': jax.random.uniform(ks[4], (DEPTH, RWKV_IN), F32),
        'rwkv_w0': n(ks[5], (DEPTH, MIX_W), 0.5),
        'rwkv_w_up': n(ks[6], (DEPTH, DECAY_LORA, MIX_W), DECAY_LORA ** -0.5),
        'rwkv_a0': n(ks[7], (DEPTH, MIX_W), 0.1),
        'rwkv_a_up': n(ks[8], (DEPTH, ICL_LORA, MIX_W), ICL_LORA ** -0.5),
        'rwkv_g_up': n(ks[9], (DEPTH, GATE_LORA, MIX_W), GATE_LORA ** -0.5),
        'rwkv_k_k': 0.85 + n(ks[10], (DEPTH, MIX_W), 0.05),
        'rwkv_k_a': 1.0 + n(ks[11], (DEPTH, MIX_W), 0.05),
        'rwkv_r_k': n(ks[12], (DEPTH, MIX_W), 0.1),
        'rwkv_ln_g': 1.0 + n(ks[13], (DEPTH, MIX_W), 0.02),
        'rwkv_ln_b': n(ks[14], (DEPTH, MIX_W), 0.02),
        'hgrn_lb_logits': 1.0 + n(ks[15], (DEPTH, MIX_W), 0.1),
        'hgrn_norm_g': 1.0 + n(ks[16], (DEPTH, MIX_W), 0.02),
        'w_branch_up': n(ks[17], (DEPTH, N_BRANCH, MIX_W, D_MODEL), MIX_W ** -0.5),
        'w_out': n(ks[18], (DEPTH, D_MODEL, D_MODEL), BETA * D_MODEL ** -0.5),
        'ln1_g': 1.0 + n(ks[19], (DEPTH, D_MODEL), 0.02),
        'ln1_b': n(ks[20], (DEPTH, D_MODEL), 0.02),
        'w_ffn_in': n(ks[21], (DEPTH, D_MODEL, 2 * D_FF), D_MODEL ** -0.5),
        'w_ffn_out': n(ks[22], (DEPTH, D_FF, D_MODEL), BETA * D_FF ** -0.5),
        'ln2_g': 1.0 + n(ks[23], (DEPTH, D_MODEL), 0.02),
        'ln2_b': n(ks[24], (DEPTH, D_MODEL), 0.02),
    }


def reference(x, ln_in_g, ln_in_b, w_in, rwkv_mu, rwkv_w0, rwkv_w_up, rwkv_a0, rwkv_a_up,
              rwkv_g_up, rwkv_k_k, rwkv_k_a, rwkv_r_k, rwkv_ln_g, rwkv_ln_b, hgrn_lb_logits,
              hgrn_norm_g, w_branch_up, w_out, ln1_g, ln1_b, w_ffn_in, w_ffn_out, ln2_g, ln2_b):
    B, T, _ = x.shape
    h = _layer_norm(x, ln_in_g, ln_in_b)
    lb_p = jax.nn.softmax(hgrn_lb_logits.astype(F32), axis=0)
    lower_bounds = jnp.cumsum(lb_p, axis=0) - lb_p[0:1]
    for l in range(DEPTH):
        p = h @ w_in[l]
        q_sb, k_sb, v_sb, p_rw, q_hg, f_hg, i_hg, g_hg, p_gate = _split(
            p, [MIX_W] * 3 + [RWKV_IN] + [MIX_W] * 4 + [N_BRANCH * D_MODEL])
        y_sb = stick_breaking_attention(_heads(q_sb, SB_HEADS), _heads(k_sb, SB_HEADS),
                                        _heads(v_sb, SB_HEADS))
        y_rw = rwkv7_time_mix(p_rw, rwkv_mu[l], rwkv_w0[l], rwkv_w_up[l], rwkv_a0[l],
                              rwkv_a_up[l], rwkv_g_up[l], rwkv_k_k[l], rwkv_k_a[l],
                              rwkv_r_k[l], rwkv_ln_g[l], rwkv_ln_b[l])
        y_hg = hgrn2_mix(q_hg, f_hg, i_hg, g_hg, lower_bounds[l], hgrn_norm_g[l])
        gates = jax.nn.sigmoid(p_gate).reshape(B, T, N_BRANCH, D_MODEL)
        merged = (gates[:, :, 0] * (y_sb @ w_branch_up[l, 0])
                  + gates[:, :, 1] * (y_rw @ w_branch_up[l, 1])
                  + gates[:, :, 2] * (y_hg @ w_branch_up[l, 2]))
        h = _layer_norm(ALPHA * h + merged @ w_out[l], ln1_g[l], ln1_b[l])
        h = _layer_norm(ALPHA * h + _swiglu(h, w_ffn_in[l], w_ffn_out[l]), ln2_g[l], ln2_b[l])
    return h.astype(x.dtype)
```

```cpp
#include <hip/hip_runtime.h>
#include <hip/hip_cooperative_groups.h>
#include <cstdio>
#include <cstdint>
namespace cg = cooperative_groups;

namespace pg8 {
#define PG8_LAS __attribute__((address_space(3)))
typedef unsigned short bf16_t;
typedef short bf16x8 __attribute__((ext_vector_type(8)));
typedef float f32x4 __attribute__((ext_vector_type(4)));
typedef unsigned u32x4 __attribute__((ext_vector_type(4)));
constexpr int BM = 256, BK = 64, HALF = 128, HTB = HALF * BK * 2, STAGE_BYTES = 8 * HTB, NXCD = 8, WGM = 8;

__host__ __device__ __forceinline__ int lds_byte(int r, int c) { const int st = (r >> 4) * 2 + (c >> 5), rr = r & 15, cc = c & 31, ob = rr * 64 + cc * 2; return st * 1024 + (ob ^ (((ob >> 9) & 1) << 5)); }
__host__ __device__ __forceinline__ void stage_rc(int b, int& R, int& C) { const int st = b / 1024, sb = b % 1024, swz = sb ^ (((sb >> 9) & 1) << 5); R = (st >> 1) * 16 + swz / 64; C = (st & 1) * 32 + (swz % 64) / 2; }
__host__ __device__ __forceinline__ int perm32(int rho) { const int n = rho >> 4, i = rho & 15; return 8 * (i >> 2) + 4 * n + (i & 3); }

struct Unit { int pm, pn, koff; };
struct Gemm { const bf16_t* A; const bf16_t* Bt; int M, N, K, lda; };

struct StaticOrder {
    int nM, nN, nwg, G, c;
    __host__ __device__ void init(int M, int N, int G_, int c_) { nM = M / BM; nN = N / BM; nwg = nM * nN; G = G_; c = c_; }
    __host__ __device__ bool next(int i, Unit& u) const {
        const long L = (long)i * G + c; if (L >= nwg) return false;
        int wgid = (int)L; { const int q = nwg / NXCD, r = nwg % NXCD, xcd = wgid % NXCD, off = wgid / NXCD; wgid = (xcd < r ? xcd * (q + 1) : r * (q + 1) + (xcd - r) * q) + off; }
        const int nig = WGM * nN, gid = wgid / nig, fm = gid * WGM, gsz = (nM - fm) < WGM ? (nM - fm) : WGM;
        u.pm = fm + ((wgid % nig) % gsz); u.pn = (wgid % nig) / gsz; u.koff = 0; return true;
    }
    __device__ __forceinline__ void a_ready(const Unit&) const {}
    __device__ __forceinline__ void done(const Unit&) const {}
};
struct BranchOrder {
    int G, c;
    __host__ __device__ bool next(int i, Unit& u) const {
        const int j = i / 3, br = i - 3 * j; const long L = (long)j * G + c; if (L >= 256) return false;
        u.pm = (int)(L >> 2); u.pn = br * 4 + (int)(L & 3); u.koff = br * 512; return true;
    }
    __device__ __forceinline__ void a_ready(const Unit&) const {}
    __device__ __forceinline__ void done(const Unit&) const {}
};

__device__ __forceinline__ unsigned cvt_pk_bf16(float lo, float hi) { unsigned r; asm volatile("v_cvt_pk_bf16_f32 %0, %1, %2" : "=v"(r) : "v"(lo), "v"(hi)); return r; }
__device__ __forceinline__ float bf2f(unsigned short b) { return __uint_as_float((unsigned)b << 16); }
__device__ __forceinline__ float sigmoidf_(float x) { return __builtin_amdgcn_rcpf(1.0f + __expf(-x)); }
__device__ __forceinline__ u32x4 pack8(const f32x4 v0, const f32x4 v1) { u32x4 w; w.x = cvt_pk_bf16(v0[0], v0[1]); w.y = cvt_pk_bf16(v0[2], v0[3]); w.z = cvt_pk_bf16(v1[0], v1[1]); w.w = cvt_pk_bf16(v1[2], v1[3]); return w; }
__device__ __forceinline__ void unpack8(const u32x4 w, f32x4& v0, f32x4& v1) {
    v0[0] = __uint_as_float(w.x << 16); v0[1] = __uint_as_float(w.x & 0xffff0000u); v0[2] = __uint_as_float(w.y << 16); v0[3] = __uint_as_float(w.y & 0xffff0000u);
    v1[0] = __uint_as_float(w.z << 16); v1[1] = __uint_as_float(w.z & 0xffff0000u); v1[2] = __uint_as_float(w.w << 16); v1[3] = __uint_as_float(w.w & 0xffff0000u); }

constexpr int T_SEQ = 2048;
struct Epi1 {
    static constexpr bool PERM = true, AFTER_DRAIN = false;
    bf16_t *QK, *VT, *PRW, *HG, *GATE;
    __device__ __forceinline__ void operator()(const f32x4 (&acc)[2][2][4][2], const Unit& u, int wr, int wc, int fr, int fq) const {
        const int pn = u.pn; const int row0 = u.pm * BM + wr * 64 + fr;
        if (pn == 4 || pn == 5) {
#pragma unroll
            for (int ai = 0; ai < 2; ++ai)
#pragma unroll
                for (int m = 0; m < 4; ++m) { const int row = row0 + ai * HALF + m * 16; const int b = row >> 11, t = row & (T_SEQ - 1);
#pragma unroll
                    for (int bj = 0; bj < 2; ++bj)
#pragma unroll
                        for (int n = 0; n < 2; ++n) { const int cv = (pn - 4) * 256 + bj * HALF + wc * 32 + 8 * fq + 4 * n; const int hh = cv >> 6, d = cv & 63;
                            bf16_t* p = VT + ((size_t)((b * 8 + hh) * 64 + d)) * T_SEQ + t; const f32x4 v = acc[ai][bj][m][n];
                            const unsigned w0 = cvt_pk_bf16(v[0], v[1]), w1 = cvt_pk_bf16(v[2], v[3]);
                            p[0] = (bf16_t)(w0 & 0xffffu); p[T_SEQ] = (bf16_t)(w0 >> 16); p[2 * T_SEQ] = (bf16_t)(w1 & 0xffffu); p[3 * T_SEQ] = (bf16_t)(w1 >> 16); } }
            return;
        }
        bf16_t* base; int ldc, colt; bool sig = false;
        if (pn < 4) { base = QK; ldc = 1024; colt = pn * 256; }
        else if (pn < 13) { base = PRW; ldc = 1792; colt = (pn - 6) * 256; }
        else if (pn < 21) { base = HG; ldc = 2048; colt = (pn - 13) * 256; }
        else { base = GATE; ldc = 3072; colt = (pn - 21) * 256; sig = true; }
        const int col0 = colt + wc * 32 + 8 * fq;
#pragma unroll
        for (int ai = 0; ai < 2; ++ai)
#pragma unroll
            for (int m = 0; m < 4; ++m) { bf16_t* rowp = base + (size_t)(row0 + ai * HALF + m * 16) * ldc + col0;
#pragma unroll
                for (int bj = 0; bj < 2; ++bj) { f32x4 v0 = acc[ai][bj][m][0], v1 = acc[ai][bj][m][1];
                    if (sig) {
#pragma unroll
                        for (int j = 0; j < 4; ++j) { v0[j] = sigmoidf_(v0[j]); v1[j] = sigmoidf_(v1[j]); } }
                    *(u32x4*)(rowp + bj * HALF) = pack8(v0, v1); } }
    }
};
struct EpiLora {
    static constexpr bool PERM = true, AFTER_DRAIN = false;
    float* LWA; bf16_t* LG;
    __device__ __forceinline__ void operator()(const f32x4 (&acc)[2][2][4][2], const Unit& u, int wr, int wc, int fr, int fq) const {
        const int pn = u.pn; const int row0 = u.pm * BM + wr * 64 + fr;
        if (pn < 4) { float* base = LWA + (size_t)row0 * 1024 + pn * 256 + wc * 32 + 8 * fq;
#pragma unroll
            for (int ai = 0; ai < 2; ++ai)
#pragma unroll
                for (int m = 0; m < 4; ++m) { float* p = base + (size_t)(ai * HALF + m * 16) * 1024;
#pragma unroll
                    for (int bj = 0; bj < 2; ++bj) { *(f32x4*)(p + bj * HALF) = acc[ai][bj][m][0]; *(f32x4*)(p + bj * HALF + 4) = acc[ai][bj][m][1]; }
                    asm volatile("" ::: "memory"); }
        } else { bf16_t* base = LG + (size_t)row0 * 512 + (pn - 4) * 256 + wc * 32 + 8 * fq;
#pragma unroll
            for (int ai = 0; ai < 2; ++ai)
#pragma unroll
                for (int m = 0; m < 4; ++m) { bf16_t* p = base + (size_t)(ai * HALF + m * 16) * 512;
#pragma unroll
                    for (int bj = 0; bj < 2; ++bj) *(u32x4*)(p + bj * HALF) = pack8(acc[ai][bj][m][0], acc[ai][bj][m][1]);
                    asm volatile("" ::: "memory"); }
        }
    }
};
struct Epi2 {
    static constexpr bool PERM = true, AFTER_DRAIN = false;
    const bf16_t* GATE; float* MG; bf16_t* MERGED;
    __device__ __forceinline__ void operator()(const f32x4 (&acc)[2][2][4][2], const Unit& u, int wr, int wc, int fr, int fq) const {
        const int br = u.pn >> 2, pc = u.pn & 3; const int row0 = u.pm * BM + wr * 64 + fr; const int col0 = pc * 256 + wc * 32 + 8 * fq;
#pragma unroll
        for (int ai = 0; ai < 2; ++ai)
#pragma unroll
            for (int m = 0; m < 4; ++m) { const size_t row = (size_t)(row0 + ai * HALF + m * 16);
#pragma unroll
                for (int bj = 0; bj < 2; ++bj) { const int col = col0 + bj * HALF;
                    const u32x4 gw = *(const u32x4*)(GATE + row * 3072 + br * 1024 + col); f32x4 g0, g1; unpack8(gw, g0, g1);
                    f32x4 v0 = acc[ai][bj][m][0] * g0, v1 = acc[ai][bj][m][1] * g1; float* mp = MG + row * 1024 + col;
                    if (br > 0) { v0 += *(const f32x4*)mp; v1 += *(const f32x4*)(mp + 4); }
                    if (br < 2) { *(f32x4*)mp = v0; *(f32x4*)(mp + 4) = v1; }
                    else *(u32x4*)(MERGED + row * 1024 + col) = pack8(v0, v1); } }
    }
};
struct Epi3 {
    static constexpr bool PERM = true, AFTER_DRAIN = false;
    const float* H; float* U; float alpha;
    __device__ __forceinline__ void operator()(const f32x4 (&acc)[2][2][4][2], const Unit& u, int wr, int wc, int fr, int fq) const {
        const int row0 = u.pm * BM + wr * 64 + fr; const int col0 = u.pn * 256 + wc * 32 + 8 * fq;
#pragma unroll
        for (int ai = 0; ai < 2; ++ai)
#pragma unroll
            for (int m = 0; m < 4; ++m) { const size_t off = (size_t)(row0 + ai * HALF + m * 16) * 1024 + col0;
#pragma unroll
                for (int bj = 0; bj < 2; ++bj) { const float* hp = H + off + bj * HALF; float* up = U + off + bj * HALF;
                    const f32x4 h0 = *(const f32x4*)hp, h1 = *(const f32x4*)(hp + 4);
                    *(f32x4*)up = h0 * alpha + acc[ai][bj][m][0]; *(f32x4*)(up + 4) = h1 * alpha + acc[ai][bj][m][1]; } }
    }
};
struct Epi4 {
    static constexpr bool PERM = true, AFTER_DRAIN = false;
    bf16_t* ACT;
    __device__ __forceinline__ void operator()(const f32x4 (&acc)[2][2][4][2], const Unit& u, int wr, int wc, int fr, int fq) const {
        const int row0 = u.pm * BM + wr * 64 + fr; const int col0 = u.pn * 128 + wc * 32 + 8 * fq;
#pragma unroll
        for (int ai = 0; ai < 2; ++ai)
#pragma unroll
            for (int m = 0; m < 4; ++m) { f32x4 v0, v1;
#pragma unroll
                for (int j = 0; j < 4; ++j) { const float a0 = acc[ai][0][m][0][j], a1 = acc[ai][0][m][1][j];
                    v0[j] = a0 * sigmoidf_(a0) * acc[ai][1][m][0][j]; v1[j] = a1 * sigmoidf_(a1) * acc[ai][1][m][1][j]; }
                *(u32x4*)(ACT + (size_t)(row0 + ai * HALF + m * 16) * 2816 + col0) = pack8(v0, v1); }
    }
};
template <class Epi, class Sched, bool ALIGN_EPI = false, bool SP2 = false>
__device__ __forceinline__ void gemm_phase(PG8_LAS unsigned char* lds, const Gemm g, const Sched& S, const Epi& E) {
    int tid_o = threadIdx.x; asm volatile("" : "+v"(tid_o));
    const int tid = tid_o, wid = __builtin_amdgcn_readfirstlane(tid >> 6), lane = tid & 63, wr = wid >> 2, wc = wid & 3, fr = lane & 15, fq = lane >> 4;
    const int K = g.K, nt = K / BK;
    unsigned voffA[2], voffB[2];
#pragma unroll
    for (int i = 0; i < 2; ++i) { int R, C; stage_rc(tid * 16 + i * 8192, R, C); const int Rb = Epi::PERM ? ((R & ~31) + perm32(R & 31)) : R;
        voffA[i] = (unsigned)(R * g.lda + C) * 2u; voffB[i] = (unsigned)(Rb * K + C) * 2u; }
    const size_t kstep = (size_t)(BK * 2);
    const size_t hstep = (size_t)HALF * K * 2;
    const size_t tstep = 2 * hstep; const size_t hstepA = (size_t)HALF * g.lda * 2, tstepA = 2 * hstepA;
    const unsigned ldsw = (unsigned)wid * 1024u;
    const int aoff = lds_byte(wr * 64 + fr, fq * 8), boff = lds_byte(wc * 32 + fr, fq * 8);
#define PG8_SA(b, h) (((b) * 2 + (h)) * HTB)
#define PG8_SB(b, h) ((4 + (b) * 2 + (h)) * HTB)
#define PG8_STAGE(bufoff, gbase, voff) do { _Pragma("unroll") for (int _i = 0; _i < 2; ++_i) \
        __builtin_amdgcn_global_load_lds((const unsigned*)((const char*)(gbase) + (voff)[_i]), (PG8_LAS unsigned*)(lds + (bufoff) + ldsw + _i * 8192), 16, 0, 0); } while (0)
#define PG8_LDA(dst, b, h) do { _Pragma("unroll") for (int m = 0; m < 4; ++m) _Pragma("unroll") for (int k = 0; k < 2; ++k) dst[m][k] = *(const PG8_LAS bf16x8*)(lds + PG8_SA(b, h) + aoff + m * 2048 + k * 1024); } while (0)
#define PG8_LDB(dst, b, h) do { _Pragma("unroll") for (int n = 0; n < 2; ++n) _Pragma("unroll") for (int k = 0; k < 2; ++k) dst[n][k] = *(const PG8_LAS bf16x8*)(lds + PG8_SB(b, h) + boff + n * 2048 + k * 1024); } while (0)
#define PG8_MMA(ai, bj, At, Bt) do { __builtin_amdgcn_s_setprio(1); _Pragma("unroll") for (int m = 0; m < 4; ++m) _Pragma("unroll") for (int n = 0; n < 2; ++n) _Pragma("unroll") for (int k = 0; k < 2; ++k) \
        acc[ai][bj][m][n] = __builtin_amdgcn_mfma_f32_16x16x32_bf16(Bt[n][k], At[m][k], acc[ai][bj][m][n], 0, 0, 0); __builtin_amdgcn_s_setprio(0); } while (0)
#define PG8_WAIT_V(n) asm volatile("s_waitcnt vmcnt(" #n ")" ::: "memory")
#define PG8_WAIT_L(n) asm volatile("s_waitcnt lgkmcnt(" #n ")" ::: "memory")
#define PG8_BAR __builtin_amdgcn_s_barrier()
#define PG8_SCHED __builtin_amdgcn_sched_barrier(0)
    Unit cur, nxt; int ui = 0;
    if (!S.next(0, cur)) return;
    f32x4 acc[2][2][4][2];
#pragma unroll
    for (int a = 0; a < 2; ++a)
#pragma unroll
        for (int b = 0; b < 2; ++b)
#pragma unroll
            for (int m = 0; m < 4; ++m)
#pragma unroll
                for (int n = 0; n < 2; ++n) acc[a][b][m][n] = (f32x4){0.f, 0.f, 0.f, 0.f};
    bf16x8 At[4][2], B0[2][2], B1[2][2];
    const char* cA = (const char*)g.A + (size_t)cur.pm * tstepA + (size_t)cur.koff * 2; const char* cB = (const char*)g.Bt + (size_t)cur.pn * tstep;
    S.a_ready(cur);
    if constexpr (SP2) {
        PG8_STAGE(PG8_SB(0, 0), cB, voffB); PG8_STAGE(PG8_SB(0, 1), cB + hstep, voffB); PG8_STAGE(PG8_SA(0, 0), cA, voffA); PG8_STAGE(PG8_SA(0, 1), cA + hstepA, voffA);
        if (wr == 1) PG8_BAR;
        PG8_WAIT_V(2); PG8_BAR;
        PG8_STAGE(PG8_SB(1, 0), cB + kstep, voffB); PG8_STAGE(PG8_SA(1, 0), cA + kstep, voffA); PG8_STAGE(PG8_SB(1, 1), cB + hstep + kstep, voffB);
        PG8_WAIT_V(6); PG8_BAR;
    } else {
        PG8_STAGE(PG8_SB(0, 0), cB, voffB); PG8_STAGE(PG8_SA(0, 0), cA, voffA); PG8_STAGE(PG8_SB(0, 1), cB + hstep, voffB); PG8_STAGE(PG8_SA(0, 1), cA + hstepA, voffA);
        if (wr == 1) PG8_BAR;
        PG8_WAIT_V(4); PG8_BAR;
        PG8_STAGE(PG8_SB(1, 0), cB + kstep, voffB); PG8_STAGE(PG8_SA(1, 0), cA + kstep, voffA); PG8_STAGE(PG8_SB(1, 1), cB + hstep + kstep, voffB);
        PG8_WAIT_V(6); PG8_BAR;
    }
    for (;;) {
        const bool has_next = S.next(ui + 1, nxt);
        const char* nA = has_next ? (const char*)g.A + (size_t)nxt.pm * tstepA + (size_t)nxt.koff * 2 : cA; const char* nB = has_next ? (const char*)g.Bt + (size_t)nxt.pn * tstep : cB;
        for (int t = 0; t < nt; t += 2) {
            const bool last = (t == nt - 2);
            const char* a1 = cA + (size_t)(t + 1) * kstep;
            const char* a2 = last ? nA : cA + (size_t)(t + 2) * kstep; const char* b2 = last ? nB : cB + (size_t)(t + 2) * kstep;
            const char* a3 = a2 + kstep; const char* b3 = b2 + kstep;
            if (last && has_next) S.a_ready(nxt);
            if constexpr (SP2) {
            PG8_LDB(B0, 0, 0); PG8_LDB(B1, 0, 1); PG8_SCHED; PG8_LDA(At, 0, 0); PG8_STAGE(PG8_SA(1, 1), a1 + hstepA, voffA);
            PG8_WAIT_V(8); PG8_WAIT_L(0); PG8_BAR; PG8_MMA(0, 0, At, B0); PG8_MMA(0, 1, At, B1); PG8_BAR; PG8_SCHED;
            PG8_LDA(At, 0, 1); PG8_STAGE(PG8_SB(0, 0), b2, voffB); PG8_STAGE(PG8_SB(0, 1), b2 + hstep, voffB); PG8_STAGE(PG8_SA(0, 0), a2, voffA);
            PG8_WAIT_V(8); PG8_WAIT_L(0); PG8_BAR; PG8_MMA(1, 0, At, B0); PG8_MMA(1, 1, At, B1); PG8_BAR; PG8_SCHED;
            PG8_LDB(B0, 1, 0); PG8_LDB(B1, 1, 1); PG8_SCHED; PG8_LDA(At, 1, 0); PG8_STAGE(PG8_SA(0, 1), a2 + hstepA, voffA);
            PG8_WAIT_V(8); PG8_WAIT_L(0); PG8_BAR; PG8_MMA(0, 0, At, B0); PG8_MMA(0, 1, At, B1); PG8_BAR; PG8_SCHED;
            PG8_LDA(At, 1, 1); PG8_STAGE(PG8_SB(1, 0), b3, voffB); PG8_STAGE(PG8_SB(1, 1), b3 + hstep, voffB); PG8_STAGE(PG8_SA(1, 0), a3, voffA);
            PG8_WAIT_V(8); PG8_WAIT_L(0); PG8_BAR; PG8_MMA(1, 0, At, B0); PG8_MMA(1, 1, At, B1); PG8_BAR; PG8_SCHED;
            } else {
            PG8_LDB(B0, 0, 0); PG8_SCHED; PG8_LDA(At, 0, 0); PG8_STAGE(PG8_SA(1, 1), a1 + hstepA, voffA);
            PG8_WAIT_L(8); PG8_BAR; PG8_WAIT_L(0); PG8_MMA(0, 0, At, B0); PG8_BAR; PG8_SCHED;
            PG8_LDB(B1, 0, 1); PG8_STAGE(PG8_SB(0, 0), b2, voffB);
            PG8_BAR; PG8_WAIT_L(0); PG8_MMA(0, 1, At, B1); PG8_BAR;
            PG8_LDA(At, 0, 1); PG8_STAGE(PG8_SA(0, 0), a2, voffA);
            PG8_BAR; PG8_WAIT_L(0); PG8_MMA(1, 0, At, B0); PG8_BAR; PG8_SCHED;
            PG8_STAGE(PG8_SB(0, 1), b2 + hstep, voffB);
            PG8_WAIT_V(6); PG8_BAR; PG8_MMA(1, 1, At, B1); PG8_BAR;
            PG8_LDB(B0, 1, 0); PG8_SCHED; PG8_LDA(At, 1, 0); PG8_STAGE(PG8_SA(0, 1), a2 + hstepA, voffA);
            PG8_WAIT_L(8); PG8_BAR; PG8_WAIT_L(0); PG8_MMA(0, 0, At, B0); PG8_BAR; PG8_SCHED;
            PG8_LDB(B1, 1, 1); PG8_STAGE(PG8_SB(1, 0), b3, voffB);
            PG8_BAR; PG8_WAIT_L(0); PG8_MMA(0, 1, At, B1); PG8_BAR;
            PG8_LDA(At, 1, 1); PG8_STAGE(PG8_SA(1, 0), a3, voffA);
            PG8_BAR; PG8_WAIT_L(0); PG8_MMA(1, 0, At, B0); PG8_BAR; PG8_SCHED;
            PG8_STAGE(PG8_SB(1, 1), b3 + hstep, voffB);
            PG8_WAIT_V(6); PG8_BAR; PG8_MMA(1, 1, At, B1); PG8_BAR;
            }
        }
        if constexpr (ALIGN_EPI) { if (wr == 0) PG8_BAR; }
        if constexpr (!Epi::AFTER_DRAIN) { E(acc, cur, wr, wc, fr, fq); S.done(cur); }
        if (!has_next) break;
#pragma unroll
        for (int a = 0; a < 2; ++a)
#pragma unroll
            for (int b = 0; b < 2; ++b)
#pragma unroll
                for (int m = 0; m < 4; ++m)
#pragma unroll
                    for (int n = 0; n < 2; ++n) acc[a][b][m][n] = (f32x4){0.f, 0.f, 0.f, 0.f};
        cur = nxt; cA = nA; cB = nB; ++ui;
        if constexpr (ALIGN_EPI) { if (wr == 1) PG8_BAR; }
    }
    PG8_WAIT_V(0);
    if constexpr (!ALIGN_EPI) { if (wr == 0) PG8_BAR; }
    PG8_BAR;
    if constexpr (Epi::AFTER_DRAIN) { E.fused(acc, cur, wr, wc, fr, fq, lds, wid, lane); S.done(cur); }
#undef PG8_SA
#undef PG8_SB
#undef PG8_STAGE
#undef PG8_LDA
#undef PG8_LDB
#undef PG8_MMA
#undef PG8_WAIT_V
#undef PG8_WAIT_L
#undef PG8_BAR
#undef PG8_SCHED
}
}

typedef unsigned short bf16;
typedef short bf16x8 __attribute__((ext_vector_type(8)));
typedef float f32x4 __attribute__((ext_vector_type(4)));
typedef float f32x16 __attribute__((ext_vector_type(16)));
typedef unsigned v4u __attribute__((ext_vector_type(4)));
#define LAS __attribute__((address_space(3)))
constexpr int NB = 8, TS = 2048, M = NB * TS, D = 1024, DEPTH = 4, MIXW = 512, RWIN = 1792, INC = 8448, DFF = 2816;
constexpr float ALPHA = 1.681792830507429f;
constexpr float LN_EPS = 1e-5f, GN_EPS = 64e-5f, RMS_EPS = 1e-6f;
constexpr size_t MiB = 1u << 20;
constexpr size_t WS_WIN = 1 * MiB, WS_WUP = 18 * MiB, WS_WOUT = 21 * MiB, WS_WFI = 23 * MiB, WS_WFO = 34 * MiB, WS_WLORA = 40 * MiB, WS_BON = 41 * MiB;
constexpr size_t WS_H = 42 * MiB, WS_HB = 106 * MiB, WS_QK = 138 * MiB, WS_VT = 170 * MiB, WS_HG = 186 * MiB, WS_PRW = 250 * MiB, WS_GATE = 306 * MiB;
constexpr size_t WS_Y = 402 * MiB, WS_T = 450 * MiB, WS_LWA = 458 * MiB, WS_END = 522 * MiB;
constexpr size_t WS_LG = 138 * MiB, WS_YRAW = 154 * MiB, WS_MG = 138 * MiB, WS_MERGED = 202 * MiB, WS_U = 250 * MiB, WS_ACT = 314 * MiB;
constexpr int LDS_BYTES = 147456;
constexpr int NWAVES = 8;

struct Args { const float* in[25]; float* out; unsigned char* ws; };

__device__ __forceinline__ float bf2f(bf16 b) { return __uint_as_float((unsigned)b << 16); }
__device__ __forceinline__ bf16 f2bf(float f) { return (bf16)(pg8::cvt_pk_bf16(f, 0.f) & 0xffffu); }
__device__ __forceinline__ float sigm(float x) { return __builtin_amdgcn_rcpf(1.0f + __expf(-x)); }
__device__ __forceinline__ float wave_sum(float v) {
#pragma unroll
    for (int o = 1; o < 64; o <<= 1) v += __shfl_xor(v, o);
    return v;
}
template <int CTRL> __device__ __forceinline__ float dppf(float x) { return __builtin_bit_cast(float, __builtin_amdgcn_update_dpp(0, __builtin_bit_cast(int, x), CTRL, 0xF, 0xF, true)); }
__device__ __forceinline__ float row16_sum(float x) {
    x += dppf<0xB1>(x); x += dppf<0x4E>(x); x += dppf<0x141>(x); x += dppf<0x140>(x); return x;
}
#define LDS_WAIT() asm volatile("s_waitcnt lgkmcnt(0)" ::: "memory")

__device__ __forceinline__ void transpose_item(const float* W, int K, int N, bf16* WT, int k0, int n0, int drow0, LAS float* scr, int lane) {
#pragma unroll 8
    for (int i = 0; i < 32; ++i) { const int kk = 2 * i + (lane >> 5); scr[kk * 33 + (lane & 31)] = W[(size_t)(k0 + kk) * N + n0 + (lane & 31)]; }
    LDS_WAIT(); asm volatile("" ::: "memory");
    const int c = lane & 7;
#pragma unroll
    for (int j = 0; j < 4; ++j) { const int n = (lane >> 3) + 8 * j; const LAS float* s = scr + (8 * c) * 33 + n;
        v4u o; o.x = pg8::cvt_pk_bf16(s[0 * 33], s[1 * 33]); o.y = pg8::cvt_pk_bf16(s[2 * 33], s[3 * 33]); o.z = pg8::cvt_pk_bf16(s[4 * 33], s[5 * 33]); o.w = pg8::cvt_pk_bf16(s[6 * 33], s[7 * 33]);
        *(v4u*)(WT + (size_t)(drow0 + n) * K + k0 + 8 * c) = o; }
    LDS_WAIT(); asm volatile("" ::: "memory");
}
__device__ __forceinline__ void conv_weights(const Args& a, int l, LAS unsigned char* lds, int gw, int NGW, int wave, int lane) {
    unsigned char* ws = a.ws;
    LAS float* scr = (LAS float*)(lds + wave * 16384);
    const float* Win = a.in[3] + (size_t)l * D * INC; const float* Wup = a.in[17] + (size_t)l * 3 * MIXW * D; const float* Wout = a.in[18] + (size_t)l * D * D;
    const float* Wfi = a.in[21] + (size_t)l * D * 2 * DFF; const float* Wfo = a.in[22] + (size_t)l * DFF * D;
    constexpr int I_IN = (D / 64) * (INC / 32), I_UP = (MIXW / 64) * (D / 32), I_OUT = (D / 64) * (D / 32), I_FI = (D / 64) * (2 * DFF / 32), I_FO = (DFF / 64) * (D / 32);
    constexpr int NITEMS = I_IN + 3 * I_UP + I_OUT + I_FI + I_FO;
    for (int it = gw; it < NITEMS; it += NGW) {
        int r = it;
        if (r < I_IN) { const int nblk = INC / 32, kb = r / nblk, nb = r % nblk; transpose_item(Win, D, INC, (bf16*)(ws + WS_WIN), 64 * kb, 32 * nb, 32 * nb, scr, lane); continue; } r -= I_IN;
        if (r < 3 * I_UP) { const int br = r / I_UP; r -= br * I_UP; const int nblk = D / 32, kb = r / nblk, nb = r % nblk;
            transpose_item(Wup + (size_t)br * MIXW * D, MIXW, D, (bf16*)(ws + WS_WUP), 64 * kb, 32 * nb, br * D + 32 * nb, scr, lane); continue; } r -= 3 * I_UP;
        if (r < I_OUT) { const int nblk = D / 32, kb = r / nblk, nb = r % nblk; transpose_item(Wout, D, D, (bf16*)(ws + WS_WOUT), 64 * kb, 32 * nb, 32 * nb, scr, lane); continue; } r -= I_OUT;
        if (r < I_FI) { const int nblk = 2 * DFF / 32, kb = r / nblk, nb = r % nblk; const int n0 = 32 * nb; const int half = n0 >= DFF ? 1 : 0, nn = n0 - half * DFF;
            transpose_item(Wfi, D, 2 * DFF, (bf16*)(ws + WS_WFI), 64 * kb, n0, 256 * (nn >> 7) + 128 * half + (nn & 127), scr, lane); continue; } r -= I_FI;
        { const int nblk = D / 32, kb = r / nblk, nb = r % nblk; transpose_item(Wfo, DFF, D, (bf16*)(ws + WS_WFO), 64 * kb, 32 * nb, 32 * nb, scr, lane); }
    }
    const float* wu = a.in[6] + (size_t)l * 64 * MIXW; const float* au = a.in[8] + (size_t)l * 64 * MIXW; const float* gu = a.in[9] + (size_t)l * 128 * MIXW;
    bf16* WL = (bf16*)(ws + WS_WLORA);
    for (int idx = gw * 64 + lane; idx < 1536 * 256; idx += NGW * 64) { const int n = idx >> 8, k = idx & 255; float v = 0.f;
        if (n < 512) { if (k < 64) v = wu[k * MIXW + n]; } else if (n < 1024) { if (k >= 64 && k < 128) v = au[(k - 64) * MIXW + n - 512]; } else { if (k >= 128) v = gu[(k - 128) * MIXW + n - 1024]; }
        WL[idx] = f2bf(v); }
}
__device__ __forceinline__ void ln_rows(const float* src, const float* gam, const float* bet, float* dstf, bf16* dstb, int gw, int NGW, int lane) {
    for (int m = gw; m < M; m += NGW) {
        const f32x4* xr = (const f32x4*)(src + (size_t)m * D) + lane;
        f32x4 v[4]; float s = 0.f;
#pragma unroll
        for (int j = 0; j < 4; ++j) { v[j] = xr[64 * j]; s += (v[j].x + v[j].y) + (v[j].z + v[j].w); }
        const float mean = wave_sum(s) * (1.f / D); float s2 = 0.f;
#pragma unroll
        for (int j = 0; j < 4; ++j) { v[j] = v[j] - mean; s2 += (v[j].x * v[j].x + v[j].y * v[j].y) + (v[j].z * v[j].z + v[j].w * v[j].w); }
        const float rstd = 1.f / sqrtf(wave_sum(s2) * (1.f / D) + LN_EPS);
        f32x4* of = (f32x4*)(dstf + (size_t)m * D) + lane; unsigned long long* ob = (unsigned long long*)(dstb + (size_t)m * D) + lane;
#pragma unroll
        for (int j = 0; j < 4; ++j) { const f32x4 g = ((const f32x4*)gam)[lane + 64 * j], b = ((const f32x4*)bet)[lane + 64 * j]; const f32x4 o = v[j] * rstd * g + b;
            of[64 * j] = o; if (dstb) ob[64 * j] = (unsigned long long)pg8::cvt_pk_bf16(o.x, o.y) | ((unsigned long long)pg8::cvt_pk_bf16(o.z, o.w) << 32); }
    }
}
__device__ __forceinline__ void prep_lora_in(const Args& a, int l, int gtid, int NT) {
    const bf16* PRW = (const bf16*)(a.ws + WS_PRW); bf16* T = (bf16*)(a.ws + WS_T); const float* mu = a.in[4] + (size_t)l * RWIN + 1536;
    for (int idx = gtid; idx < M * 256; idx += NT) { const int t = idx >> 8, c = idx & 255; const bf16* p = PRW + (size_t)t * RWIN + 1536 + c;
        const float x = bf2f(p[0]); const float xp = (t & (TS - 1)) ? bf2f(p[-RWIN]) : 0.f; const float v = x + (xp - x) * mu[c];
        float o; if (c < 64) o = 1.f - 2.f * __builtin_amdgcn_rcpf(1.f + __expf(2.f * v)); else if (c < 128) o = v; else o = sigm(v);
        T[idx] = f2bf(o); }
}
__device__ __forceinline__ void hgrn_scan(const Args& a, int l, int u, LAS unsigned char* lds, int tid) {
    const int b = u >> 5, h = (u >> 3) & 3, vq = u & 7;
    const bf16* HG = (const bf16*)(a.ws + WS_HG); bf16* Y = (bf16*)(a.ws + WS_Y);
    LAS float* buf0 = (LAS float*)lds; LAS float* ob0 = (LAS float*)(lds + 102400);
    const bool prod = tid >= 256; const int ptid = tid & 255;
    float lb = 0.f; const int ch = ptid & 127;
    if (prod) { const float* lg = a.in[15] + h * 128 + ch; const float l0 = lg[0], l1 = lg[MIXW], l2 = lg[2 * MIXW], l3 = lg[3 * MIXW];
        const float mx = fmaxf(fmaxf(l0, l1), fmaxf(l2, l3)); const float e0 = __expf(l0 - mx), e1 = __expf(l1 - mx), e2 = __expf(l2 - mx), e3 = __expf(l3 - mx);
        const float num = (l >= 1 ? e1 : 0.f) + (l >= 2 ? e2 : 0.f) + (l >= 3 ? e3 : 0.f); lb = num / (e0 + e1 + e2 + e3); }
    const int vr = ptid >> 4, kq = ptid & 15;
    f32x4 S0 = {0.f, 0.f, 0.f, 0.f}, S1 = {0.f, 0.f, 0.f, 0.f};
    __syncthreads();
#pragma unroll 1
    for (int c = -1; c < TS / 32; ++c) {
        if (prod) {
            if (c + 1 < TS / 32) { LAS float* bp = buf0 + ((c + 1) & 1) * 12800; const size_t t0 = (size_t)b * TS + (size_t)(c + 1) * 32;
#pragma unroll 4
                for (int j = 0; j < 16; ++j) { const int tt = (ptid + 256 * j) >> 7; const bf16* row = HG + (t0 + tt) * 2048 + h * 128 + ch;
                    const float q = bf2f(row[0]), f = bf2f(row[512]); const float fg = lb + (1.f - lb) * sigm(f);
                    bp[tt * 400 + ch] = fg; bp[tt * 400 + 128 + ch] = 1.f - fg; bp[tt * 400 + 256 + ch] = q; }
#pragma unroll
                for (int j = 0; j < 2; ++j) { const int idx = ptid + 256 * j, tt = idx >> 4, vc = idx & 15; const float iv = bf2f(HG[(t0 + tt) * 2048 + 1024 + h * 128 + vq * 16 + vc]);
                    bp[tt * 400 + 384 + vc] = iv * sigm(iv); } }
            if (c >= 1) { const LAS float* op = ob0 + ((c - 1) & 1) * 512; const size_t t0 = (size_t)b * TS + (size_t)(c - 1) * 32;
#pragma unroll
                for (int j = 0; j < 2; ++j) { const int idx = ptid + 256 * j, tt = idx >> 4, vc = idx & 15; Y[(t0 + tt) * 1536 + 1024 + h * 128 + vq * 16 + vc] = f2bf(op[idx]); } }
        } else if (c >= 0) {
            const LAS float* bp = buf0 + (c & 1) * 12800 + 8 * kq; LAS float* op = ob0 + (c & 1) * 512;
#pragma unroll 4
            for (int tt = 0; tt < 32; ++tt) { const LAS float* p = bp + tt * 400;
                const f32x4 f0 = *(const LAS f32x4*)p, f1 = *(const LAS f32x4*)(p + 4), k0 = *(const LAS f32x4*)(p + 128), k1 = *(const LAS f32x4*)(p + 132), q0 = *(const LAS f32x4*)(p + 256), q1 = *(const LAS f32x4*)(p + 260);
                const float v = bp[tt * 400 + 384 - 8 * kq + vr];
                S0 = f0 * S0 + k0 * v; S1 = f1 * S1 + k1 * v;
                const f32x4 pr = S0 * q0 + S1 * q1; const float o = row16_sum((pr.x + pr.y) + (pr.z + pr.w));
                if (kq == 0) op[tt * 16 + vr] = o; }
        }
        __syncthreads();
    }
    if (prod) { const LAS float* op = ob0 + ((TS / 32 - 1) & 1) * 512; const size_t t0 = (size_t)b * TS + (size_t)(TS / 32 - 1) * 32;
#pragma unroll
        for (int j = 0; j < 2; ++j) { const int idx = ptid + 256 * j, tt = idx >> 4, vc = idx & 15; Y[(t0 + tt) * 1536 + 1024 + h * 128 + vq * 16 + vc] = f2bf(op[idx]); } }
    __syncthreads();
}
__device__ __forceinline__ void rwkv_scan(const Args& a, int l, int u, LAS unsigned char* lds, int tid) {
    const int b = u >> 5, h = (u >> 2) & 7, qt = u & 3;
    const bf16* PRW = (const bf16*)(a.ws + WS_PRW); const float* LWA = (const float*)(a.ws + WS_LWA); float* YRAW = (float*)(a.ws + WS_YRAW); float* BON = (float*)(a.ws + WS_BON);
    LAS float* buf0 = (LAS float*)lds; LAS float* ob0 = (LAS float*)(lds + 86016);
    const bool prod = tid >= 256; const int ptid = tid & 255; const int lane = tid & 63;
    const int ch = ptid & 63, cc = h * 64 + ch;
    float mu_r = 0.f, mu_k = 0.f, mu_v = 0.f, w0 = 0.f, a0 = 0.f, kkc = 0.f, kac = 0.f, rkc = 0.f;
    if (prod) { const float* mu = a.in[4] + (size_t)l * RWIN; mu_r = mu[cc]; mu_k = mu[512 + cc]; mu_v = mu[1024 + cc];
        w0 = a.in[5][l * MIXW + cc]; a0 = a.in[7][l * MIXW + cc]; kkc = a.in[10][l * MIXW + cc]; kac = a.in[11][l * MIXW + cc]; rkc = a.in[12][l * MIXW + cc]; }
    const int vr = ptid >> 4, kq = ptid & 15;
    f32x4 S = {0.f, 0.f, 0.f, 0.f};
    __syncthreads();
#pragma unroll 1
    for (int c = -1; c < TS / 32; ++c) {
        if (prod) {
            if (c + 1 < TS / 32) { LAS float* bp = buf0 + ((c + 1) & 1) * 10752; const size_t t0 = (size_t)b * TS + (size_t)(c + 1) * 32;
#pragma unroll 2
                for (int j = 0; j < 8; ++j) { const int tt = (ptid + 256 * j) >> 6; const size_t t = t0 + tt; const bf16* row = PRW + t * RWIN + cc; const bool first = ((c + 1) * 32 + tt) == 0;
                    float r = bf2f(row[0]), k = bf2f(row[512]), v = bf2f(row[1024]);
                    const float rp = first ? 0.f : bf2f(row[-RWIN]), kp_ = first ? 0.f : bf2f(row[512 - RWIN]), vp = first ? 0.f : bf2f(row[1024 - RWIN]);
                    r += (rp - r) * mu_r; k += (kp_ - k) * mu_k; v += (vp - v) * mu_v;
                    const float x = w0 + LWA[t * 1024 + cc]; const float sp = fmaxf(-x, 0.f) + __logf(1.f + __expf(-fabsf(x))); const float dec = __expf(-__expf(-sp - 0.5f));
                    const float av = sigm(a0 + LWA[t * 1024 + 512 + cc]);
                    float kk = k * kkc; const float ss = wave_sum(kk * kk); kk *= rsqrtf(fmaxf(ss, 1e-24f));
                    const float kp = k * (1.f + (av - 1.f) * kac);
                    const float bon = wave_sum(r * kp * rkc); if (qt == 0 && lane == 0) BON[t * 8 + h] = bon;
                    LAS float* rec = bp + tt * 336; rec[ch] = kk; rec[64 + ch] = dec; rec[128 + ch] = kk * av; rec[192 + ch] = kp; rec[256 + ch] = r;
                    if ((ch >> 4) == qt) rec[320 + (ch & 15)] = v; } }
            if (c >= 1) { const LAS float* op = ob0 + ((c - 1) & 1) * 512; const size_t t0 = (size_t)b * TS + (size_t)(c - 1) * 32;
#pragma unroll
                for (int j = 0; j < 2; ++j) { const int idx = ptid + 256 * j, tt = idx >> 4, vc = idx & 15; YRAW[(t0 + tt) * MIXW + h * 64 + qt * 16 + vc] = op[idx]; } }
        } else if (c >= 0) {
            const LAS float* bp = buf0 + (c & 1) * 10752; LAS float* op = ob0 + (c & 1) * 512;
#pragma unroll 4
            for (int tt = 0; tt < 32; ++tt) { const LAS float* p = bp + tt * 336 + 4 * kq;
                const f32x4 kk4 = *(const LAS f32x4*)p, w4 = *(const LAS f32x4*)(p + 64), ka4 = *(const LAS f32x4*)(p + 128), kp4 = *(const LAS f32x4*)(p + 192), r4 = *(const LAS f32x4*)(p + 256);
                const float v = bp[tt * 336 + 320 + vr];
                const f32x4 d1 = S * kk4; const float sa = row16_sum((d1.x + d1.y) + (d1.z + d1.w));
                S = S * w4 + (kp4 * v - ka4 * sa);
                const f32x4 d2 = S * r4; const float y = row16_sum((d2.x + d2.y) + (d2.z + d2.w));
                if (kq == 0) op[tt * 16 + vr] = y; }
        }
        __syncthreads();
    }
    if (prod) { const LAS float* op = ob0 + ((TS / 32 - 1) & 1) * 512; const size_t t0 = (size_t)b * TS + (size_t)(TS / 32 - 1) * 32;
#pragma unroll
        for (int j = 0; j < 2; ++j) { const int idx = ptid + 256 * j, tt = idx >> 4, vc = idx & 15; YRAW[(t0 + tt) * MIXW + h * 64 + qt * 16 + vc] = op[idx]; } }
    __syncthreads();
}
__device__ __forceinline__ void sb_attn_unit(const bf16* QK, const bf16* VT, bf16* Y, int b, int h, int qb, int lane) {
    const int ql = lane & 31, hi = lane >> 5; const int q0 = qb * 32;
    const bf16* qp = QK + ((size_t)(b * TS + q0 + ql) * 1024 + h * 64 + 8 * hi);
    bf16x8 qf[4];
#pragma unroll
    for (int ks = 0; ks < 4; ++ks) qf[ks] = *(const bf16x8*)(qp + 16 * ks);
    const int kperm = 16 * ((ql >> 2) & 1) + 4 * (ql >> 3) + (ql & 3);
    const bf16* kbase = QK + ((size_t)(b * TS + kperm) * 1024 + 512 + h * 64 + 8 * hi);
    const bf16* vbase = VT + ((size_t)((b * 8 + h) * 64 + ql)) * TS + 16 * hi;
    f32x16 o0, o1;
#pragma unroll
    for (int i = 0; i < 16; ++i) { o0[i] = 0.f; o1[i] = 0.f; }
    float carry = 0.f;
    bf16x8 kf[4];
#pragma unroll
    for (int ks = 0; ks < 4; ++ks) kf[ks] = *(const bf16x8*)(kbase + (size_t)q0 * 1024 + 16 * ks);
#pragma unroll 1
    for (int st = qb; st >= 0; --st) {
        const int k0 = st * 32;
        bf16x8 vb[4];
#pragma unroll
        for (int mm = 0; mm < 2; ++mm) { vb[2 * mm] = *(const bf16x8*)(vbase + k0 + 8 * mm); vb[2 * mm + 1] = *(const bf16x8*)(vbase + (size_t)32 * TS + k0 + 8 * mm); }
        f32x16 s;
#pragma unroll
        for (int i = 0; i < 16; ++i) s[i] = 0.f;
#pragma unroll
        for (int ks = 0; ks < 4; ++ks) s = __builtin_amdgcn_mfma_f32_32x32x16_bf16(kf[ks], qf[ks], s, 0, 0, 0);
        if (st > 0) {
#pragma unroll
            for (int ks = 0; ks < 4; ++ks) kf[ks] = *(const bf16x8*)(kbase + (size_t)(k0 - 32) * 1024 + 16 * ks);
        }
        const bool diag = (st == qb);
        float lk[16], zl[16]; float tot = 0.f;
#pragma unroll
        for (int i = 0; i < 16; ++i) { const float z = s[i] * 0.125f; const float sp = fmaxf(z, 0.f) + __logf(1.f + __expf(-fabsf(z)));
            const bool ok = !diag || (16 * hi + i < ql); lk[i] = ok ? -sp : 0.f; zl[i] = ok ? z - sp : -1e30f; tot += lk[i]; }
        const float other = __shfl_xor(tot, 32);
        float run = carry + (hi ? 0.f : other);
        float w[16];
#pragma unroll
        for (int i = 15; i >= 0; --i) { w[i] = __expf(zl[i] + run); run += lk[i]; }
        carry += tot + other;
#pragma unroll
        for (int mm = 0; mm < 2; ++mm) {
            v4u pk; pk.x = pg8::cvt_pk_bf16(w[8 * mm], w[8 * mm + 1]); pk.y = pg8::cvt_pk_bf16(w[8 * mm + 2], w[8 * mm + 3]); pk.z = pg8::cvt_pk_bf16(w[8 * mm + 4], w[8 * mm + 5]); pk.w = pg8::cvt_pk_bf16(w[8 * mm + 6], w[8 * mm + 7]);
            const bf16x8 pa = __builtin_bit_cast(bf16x8, pk);
            o0 = __builtin_amdgcn_mfma_f32_32x32x16_bf16(pa, vb[2 * mm], o0, 0, 0, 0);
            o1 = __builtin_amdgcn_mfma_f32_32x32x16_bf16(pa, vb[2 * mm + 1], o1, 0, 0, 0);
        }
        if (!__any(carry > -80.f)) break;
    }
    bf16* yp = Y + (size_t)(b * TS + q0 + 4 * hi) * 1536 + h * 64 + ql;
#pragma unroll
    for (int i = 0; i < 16; ++i) { const int row = (i & 3) + 8 * (i >> 2); yp[(size_t)row * 1536] = f2bf(o0[i]); yp[(size_t)row * 1536 + 32] = f2bf(o1[i]); }
}
__device__ __forceinline__ void post_mix(const Args& a, int l, int gw, int NGW, int lane) {
    const bf16* PRW = (const bf16*)(a.ws + WS_PRW); const float* YRAW = (const float*)(a.ws + WS_YRAW); const float* BON = (const float*)(a.ws + WS_BON);
    const bf16* LG = (const bf16*)(a.ws + WS_LG); const bf16* HG = (const bf16*)(a.ws + WS_HG); bf16* Y = (bf16*)(a.ws + WS_Y);
    const int c = 8 * lane;
    const float* mu = a.in[4] + (size_t)l * RWIN + 1024 + c; const float* gg = a.in[13] + l * MIXW + c; const float* gb = a.in[14] + l * MIXW + c; const float* ng = a.in[16] + l * MIXW + c;
    const f32x4 mu0 = *(const f32x4*)mu, mu1 = *(const f32x4*)(mu + 4), gg0 = *(const f32x4*)gg, gg1 = *(const f32x4*)(gg + 4), gb0 = *(const f32x4*)gb, gb1 = *(const f32x4*)(gb + 4), ng0 = *(const f32x4*)ng, ng1 = *(const f32x4*)(ng + 4);
    for (int t = gw; t < M; t += NGW) {
        {
            f32x4 y0 = *(const f32x4*)(YRAW + (size_t)t * MIXW + c), y1 = *(const f32x4*)(YRAW + (size_t)t * MIXW + c + 4);
            float s = (y0.x + y0.y) + (y0.z + y0.w) + (y1.x + y1.y) + (y1.z + y1.w); s += __shfl_xor(s, 1); s += __shfl_xor(s, 2); s += __shfl_xor(s, 4);
            const float mean = s * (1.f / 64.f); y0 = y0 - mean; y1 = y1 - mean;
            float q = (y0.x * y0.x + y0.y * y0.y) + (y0.z * y0.z + y0.w * y0.w) + (y1.x * y1.x + y1.y * y1.y) + (y1.z * y1.z + y1.w * y1.w); q += __shfl_xor(q, 1); q += __shfl_xor(q, 2); q += __shfl_xor(q, 4);
            const float rstd = rsqrtf(q * (1.f / 64.f) + GN_EPS);
            f32x4 v0, v1, p0, p1; pg8::unpack8(*(const v4u*)(PRW + (size_t)t * RWIN + 1024 + c), v0, v1);
            if (t & (TS - 1)) pg8::unpack8(*(const v4u*)(PRW + (size_t)(t - 1) * RWIN + 1024 + c), p0, p1); else { p0 = (f32x4){0.f, 0.f, 0.f, 0.f}; p1 = p0; }
            v0 = v0 + (p0 - v0) * mu0; v1 = v1 + (p1 - v1) * mu1;
            const float bon = BON[(size_t)t * 8 + (lane >> 3)];
            f32x4 g0, g1; pg8::unpack8(*(const v4u*)(LG + (size_t)t * MIXW + c), g0, g1);
            const f32x4 r0 = ((y0 * rstd * gg0 + gb0) + v0 * bon) * g0, r1 = ((y1 * rstd * gg1 + gb1) + v1 * bon) * g1;
            *(v4u*)(Y + (size_t)t * 1536 + 512 + c) = pg8::pack8(r0, r1);
        }
        {
            f32x4 o0, o1; pg8::unpack8(*(const v4u*)(Y + (size_t)t * 1536 + 1024 + c), o0, o1);
            float q = (o0.x * o0.x + o0.y * o0.y) + (o0.z * o0.z + o0.w * o0.w) + (o1.x * o1.x + o1.y * o1.y) + (o1.z * o1.z + o1.w * o1.w);
            q += __shfl_xor(q, 1); q += __shfl_xor(q, 2); q += __shfl_xor(q, 4); q += __shfl_xor(q, 8);
            const float rs = rsqrtf(q * (1.f / 128.f) + RMS_EPS);
            f32x4 h0, h1; pg8::unpack8(*(const v4u*)(HG + (size_t)t * 2048 + 1536 + c), h0, h1);
#pragma unroll
            for (int j = 0; j < 4; ++j) { h0[j] = h0[j] * sigm(h0[j]); h1[j] = h1[j] * sigm(h1[j]); }
            const f32x4 r0 = o0 * rs * ng0 * h0, r1 = o1 * rs * ng1 * h1;
            *(v4u*)(Y + (size_t)t * 1536 + 1024 + c) = pg8::pack8(r0, r1);
        }
    }
}
__global__ void __launch_bounds__(NWAVES * 64, 2) mk_fwd(Args a_unused) {
    extern __shared__ __attribute__((aligned(16))) unsigned char lds_raw[];
    LAS unsigned char* lds = (LAS unsigned char*)lds_raw;
    cg::grid_group grid = cg::this_grid();
    typedef const __attribute__((address_space(4))) Args* KArgs;
#define PHASE_IDS() int tid = threadIdx.x; asm volatile("" : "+v"(tid)); const int lane = tid & 63, wave = __builtin_amdgcn_readfirstlane(tid >> 6); \
    int G = gridDim.x, bid = blockIdx.x; asm volatile("" : "+s"(G), "+s"(bid)); const int gw = bid * NWAVES + wave, NGW = G * NWAVES; \
    KArgs ka = (KArgs)__builtin_amdgcn_kernarg_segment_ptr(); asm volatile("" : "+s"(ka)); const Args a = *(const Args*)ka; unsigned char* ws = a.ws; \
    float* Hf = (float*)(ws + WS_H); bf16* Hb = (bf16*)(ws + WS_HB); float* U = (float*)(ws + WS_U); (void)lane; (void)gw; (void)NGW; (void)Hf; (void)Hb; (void)U; (void)tid

    { PHASE_IDS(); ln_rows(a.in[0], a.in[1], a.in[2], Hf, Hb, gw, NGW, lane);
    conv_weights(a, 0, lds, gw, NGW, wave, lane); }
    grid.sync();

#pragma unroll 1
    for (int l = 0; l < DEPTH; ++l) {
#ifndef SKIP_PA
        { PHASE_IDS();
        { pg8::Gemm g{Hb, (const bf16*)(ws + WS_WIN), M, INC, D, D}; pg8::StaticOrder S; S.init(M, INC, G, bid);
          pg8::Epi1 E{(bf16*)(ws + WS_QK), (bf16*)(ws + WS_VT), (bf16*)(ws + WS_PRW), (bf16*)(ws + WS_HG), (bf16*)(ws + WS_GATE)};
          pg8::gemm_phase<pg8::Epi1, pg8::StaticOrder, true, true>(lds, g, S, E); }
        }
#endif
        grid.sync();
#ifndef SKIP_PB1
        { PHASE_IDS();
        prep_lora_in(a, l, bid * (NWAVES * 64) + tid, G * NWAVES * 64);
        for (int u = bid; u < 256; u += G) hgrn_scan(a, l, u, lds, tid);
        for (int wu = gw; wu < 4096; wu += NGW) { const int bh = wu & 63, qb = 63 - (wu >> 6); sb_attn_unit((const bf16*)(ws + WS_QK), (const bf16*)(ws + WS_VT), (bf16*)(ws + WS_Y), bh >> 3, bh & 7, qb, lane); }
        }
#endif
        grid.sync();
#ifndef SKIP_PB2
        { PHASE_IDS();
        { int Kl = 256; asm volatile("" : "+s"(Kl));
          pg8::Gemm g{(const bf16*)(ws + WS_T), (const bf16*)(ws + WS_WLORA), M, 1536, Kl, Kl}; pg8::StaticOrder S; S.init(M, 1536, G, bid);
          pg8::EpiLora E{(float*)(ws + WS_LWA), (bf16*)(ws + WS_LG)};
          pg8::gemm_phase<pg8::EpiLora, pg8::StaticOrder, true, true>(lds, g, S, E); }
        }
#endif
        grid.sync();
#ifndef SKIP_PB3
        { PHASE_IDS();
        for (int u = bid; u < 256; u += G) rwkv_scan(a, l, u, lds, tid);
        }
#endif
        grid.sync();
#ifndef SKIP_PB4
        { PHASE_IDS();
        post_mix(a, l, gw, NGW, lane);
        }
#endif
        grid.sync();
#ifndef SKIP_PC
        { PHASE_IDS();
        { pg8::Gemm g{(const bf16*)(ws + WS_Y), (const bf16*)(ws + WS_WUP), M, 3072, 512, 1536}; pg8::BranchOrder S{G, bid};
          pg8::Epi2 E{(const bf16*)(ws + WS_GATE), (float*)(ws + WS_MG), (bf16*)(ws + WS_MERGED)};
          pg8::gemm_phase<pg8::Epi2, pg8::BranchOrder, true, true>(lds, g, S, E); }
        }
#endif
        grid.sync();
#ifndef SKIP_PD
        { PHASE_IDS();
        { pg8::Gemm g{(const bf16*)(ws + WS_MERGED), (const bf16*)(ws + WS_WOUT), M, D, D, D}; pg8::StaticOrder S; S.init(M, D, G, bid);
          pg8::Epi3 E{Hf, U, ALPHA};
          pg8::gemm_phase<pg8::Epi3, pg8::StaticOrder, true, true>(lds, g, S, E); }
        }
#endif
        grid.sync();
#ifndef SKIP_PE
        { PHASE_IDS();
        ln_rows(U, a.in[19] + l * D, a.in[20] + l * D, Hf, Hb, gw, NGW, lane);
        }
#endif
        grid.sync();
#ifndef SKIP_PF
        { PHASE_IDS();
        { pg8::Gemm g{Hb, (const bf16*)(ws + WS_WFI), M, 2 * DFF, D, D}; pg8::StaticOrder S; S.init(M, 2 * DFF, G, bid);
          pg8::Epi4 E{(bf16*)(ws + WS_ACT)};
          pg8::gemm_phase<pg8::Epi4, pg8::StaticOrder, true, true>(lds, g, S, E); }
        }
#endif
        grid.sync();
#ifndef SKIP_PG
        { PHASE_IDS();
        { pg8::Gemm g{(const bf16*)(ws + WS_ACT), (const bf16*)(ws + WS_WFO), M, D, DFF, DFF}; pg8::StaticOrder S; S.init(M, D, G, bid);
          pg8::Epi3 E{Hf, U, ALPHA};
          pg8::gemm_phase<pg8::Epi3, pg8::StaticOrder, true, true>(lds, g, S, E); }
        }
#endif
        grid.sync();
#ifndef SKIP_PH
        { PHASE_IDS();
        if (l + 1 < DEPTH) { ln_rows(U, a.in[23] + l * D, a.in[24] + l * D, Hf, Hb, gw, NGW, lane); conv_weights(a, l + 1, lds, gw, NGW, wave, lane); grid.sync(); }
        else ln_rows(U, a.in[23] + l * D, a.in[24] + l * D, a.out, (bf16*)nullptr, gw, NGW, lane);
        }
#endif
    }
}

extern "C" void kernel_launch(void* const* d_in, const int* in_sizes, int n_in, void* d_out, int out_size, void* d_ws, size_t ws_size, hipStream_t stream) {
    static int grid = 0;
    if (grid == 0) {
        if (n_in != 25 || out_size != M * D || ws_size < WS_END) { fprintf(stderr, "kernel_launch: unexpected shapes (n_in %d, out %d, ws %zu < %zu)\n", n_in, out_size, ws_size, (size_t)WS_END); grid = -1; return; }
        int dev = 0, cus = 0, per_cu = 0;
        hipGetDevice(&dev); hipDeviceGetAttribute(&cus, hipDeviceAttributeMultiprocessorCount, dev);
        if (hipFuncSetAttribute((const void*)mk_fwd, hipFuncAttributeMaxDynamicSharedMemorySize, LDS_BYTES) != hipSuccess) { fprintf(stderr, "kernel_launch: hipFuncSetAttribute failed\n"); grid = -1; return; }
        if (hipOccupancyMaxActiveBlocksPerMultiprocessor(&per_cu, (const void*)mk_fwd, NWAVES * 64, LDS_BYTES) != hipSuccess || per_cu < 1) { fprintf(stderr, "kernel_launch: occupancy query says %d\n", per_cu); per_cu = 1; }
        (void)hipGetLastError();
        grid = cus * 1;
    }
    if (grid < 0) return;
    Args a{};
    for (int i = 0; i < 25; ++i) a.in[i] = (const float*)d_in[i];
    a.out = (float*)d_out; a.ws = (unsigned char*)d_ws;
    void* args[] = {&a};
    hipError_t e = hipLaunchCooperativeKernel((const void*)mk_fwd, dim3(grid), dim3(NWAVES * 64), args, LDS_BYTES, stream);
    if (e != hipSuccess) fprintf(stderr, "kernel_launch: cooperative launch failed: %s (grid %d)\n", hipGetErrorString(e), grid);
}
```

```cpp
#include <hip/hip_runtime.h>
#include <hip/hip_cooperative_groups.h>
#include <cstdio>
#include <cstdint>
namespace cg = cooperative_groups;

namespace pg8 {
#define PG8_LAS __attribute__((address_space(3)))
typedef unsigned short bf16_t;
typedef short bf16x8 __attribute__((ext_vector_type(8)));
typedef float f32x4 __attribute__((ext_vector_type(4)));
typedef unsigned u32x4 __attribute__((ext_vector_type(4)));
constexpr int BM = 256, BK = 64, HALF = 128, HTB = HALF * BK * 2, STAGE_BYTES = 8 * HTB, NXCD = 8, WGM = 8;

__host__ __device__ __forceinline__ int lds_byte(int r, int c) { const int st = (r >> 4) * 2 + (c >> 5), rr = r & 15, cc = c & 31, ob = rr * 64 + cc * 2; return st * 1024 + (ob ^ (((ob >> 9) & 1) << 5)); }
__host__ __device__ __forceinline__ void stage_rc(int b, int& R, int& C) { const int st = b / 1024, sb = b % 1024, swz = sb ^ (((sb >> 9) & 1) << 5); R = (st >> 1) * 16 + swz / 64; C = (st & 1) * 32 + (swz % 64) / 2; }
__host__ __device__ __forceinline__ int perm32(int rho) { const int n = rho >> 4, i = rho & 15; return 8 * (i >> 2) + 4 * n + (i & 3); }

struct Unit { int pm, pn, koff; };
struct Gemm { const bf16_t* A; const bf16_t* Bt; int M, N, K, lda; };

struct StaticOrder {
    int nM, nN, nwg, G, c;
    __host__ __device__ void init(int M, int N, int G_, int c_) { nM = M / BM; nN = N / BM; nwg = nM * nN; G = G_; c = c_; }
    __host__ __device__ bool next(int i, Unit& u) const {
        const long L = (long)i * G + c; if (L >= nwg) return false;
        int wgid = (int)L; { const int q = nwg / NXCD, r = nwg % NXCD, xcd = wgid % NXCD, off = wgid / NXCD; wgid = (xcd < r ? xcd * (q + 1) : r * (q + 1) + (xcd - r) * q) + off; }
        const int nig = WGM * nN, gid = wgid / nig, fm = gid * WGM, gsz = (nM - fm) < WGM ? (nM - fm) : WGM;
        u.pm = fm + ((wgid % nig) % gsz); u.pn = (wgid % nig) / gsz; u.koff = 0; return true;
    }
    __device__ __forceinline__ void a_ready(const Unit&) const {}
    __device__ __forceinline__ void done(const Unit&) const {}
};
struct BranchOrder {
    int G, c;
    __host__ __device__ bool next(int i, Unit& u) const {
        const int j = i / 3, br = i - 3 * j; const long L = (long)j * G + c; if (L >= 256) return false;
        u.pm = (int)(L >> 2); u.pn = br * 4 + (int)(L & 3); u.koff = br * 512; return true;
    }
    __device__ __forceinline__ void a_ready(const Unit&) const {}
    __device__ __forceinline__ void done(const Unit&) const {}
};

__device__ __forceinline__ unsigned cvt_pk_bf16(float lo, float hi) { unsigned r; asm volatile("v_cvt_pk_bf16_f32 %0, %1, %2" : "=v"(r) : "v"(lo), "v"(hi)); return r; }
__device__ __forceinline__ float bf2f(unsigned short b) { return __uint_as_float((unsigned)b << 16); }
__device__ __forceinline__ float sigmoidf_(float x) { return __builtin_amdgcn_rcpf(1.0f + __expf(-x)); }
__device__ __forceinline__ u32x4 pack8(const f32x4 v0, const f32x4 v1) { u32x4 w; w.x = cvt_pk_bf16(v0[0], v0[1]); w.y = cvt_pk_bf16(v0[2], v0[3]); w.z = cvt_pk_bf16(v1[0], v1[1]); w.w = cvt_pk_bf16(v1[2], v1[3]); return w; }
__device__ __forceinline__ void unpack8(const u32x4 w, f32x4& v0, f32x4& v1) {
    v0[0] = __uint_as_float(w.x << 16); v0[1] = __uint_as_float(w.x & 0xffff0000u); v0[2] = __uint_as_float(w.y << 16); v0[3] = __uint_as_float(w.y & 0xffff0000u);
    v1[0] = __uint_as_float(w.z << 16); v1[1] = __uint_as_float(w.z & 0xffff0000u); v1[2] = __uint_as_float(w.w << 16); v1[3] = __uint_as_float(w.w & 0xffff0000u); }

constexpr int T_SEQ = 2048;
struct Epi1 {
    static constexpr bool PERM = true, AFTER_DRAIN = false;
    bf16_t *QK, *VT, *PRW, *HG, *GATE;
    __device__ __forceinline__ void operator()(const f32x4 (&acc)[2][2][4][2], const Unit& u, int wr, int wc, int fr, int fq) const {
        const int pn = u.pn; const int row0 = u.pm * BM + wr * 64 + fr;
        if (pn == 4 || pn == 5) {
#pragma unroll
            for (int ai = 0; ai < 2; ++ai)
#pragma unroll
                for (int m = 0; m < 4; ++m) { const int row = row0 + ai * HALF + m * 16; const int b = row >> 11, t = row & (T_SEQ - 1);
#pragma unroll
                    for (int bj = 0; bj < 2; ++bj)
#pragma unroll
                        for (int n = 0; n < 2; ++n) { const int cv = (pn - 4) * 256 + bj * HALF + wc * 32 + 8 * fq + 4 * n; const int hh = cv >> 6, d = cv & 63;
                            bf16_t* p = VT + ((size_t)((b * 8 + hh) * 64 + d)) * T_SEQ + t; const f32x4 v = acc[ai][bj][m][n];
                            const unsigned w0 = cvt_pk_bf16(v[0], v[1]), w1 = cvt_pk_bf16(v[2], v[3]);
                            p[0] = (bf16_t)(w0 & 0xffffu); p[T_SEQ] = (bf16_t)(w0 >> 16); p[2 * T_SEQ] = (bf16_t)(w1 & 0xffffu); p[3 * T_SEQ] = (bf16_t)(w1 >> 16); } }
            return;
        }
        bf16_t* base; int ldc, colt; bool sig = false;
        if (pn < 4) { base = QK; ldc = 1024; colt = pn * 256; }
        else if (pn < 13) { base = PRW; ldc = 1792; colt = (pn - 6) * 256; }
        else if (pn < 21) { base = HG; ldc = 2048; colt = (pn - 13) * 256; }
        else { base = GATE; ldc = 3072; colt = (pn - 21) * 256; sig = true; }
        const int col0 = colt + wc * 32 + 8 * fq;
#pragma unroll
        for (int ai = 0; ai < 2; ++ai)
#pragma unroll
            for (int m = 0; m < 4; ++m) { bf16_t* rowp = base + (size_t)(row0 + ai * HALF + m * 16) * ldc + col0;
#pragma unroll
                for (int bj = 0; bj < 2; ++bj) { f32x4 v0 = acc[ai][bj][m][0], v1 = acc[ai][bj][m][1];
                    if (sig) {
#pragma unroll
                        for (int j = 0; j < 4; ++j) { v0[j] = sigmoidf_(v0[j]); v1[j] = sigmoidf_(v1[j]); } }
                    *(u32x4*)(rowp + bj * HALF) = pack8(v0, v1); } }
    }
};
struct EpiLora {
    static constexpr bool PERM = true, AFTER_DRAIN = false;
    float* LWA; bf16_t* LG;
    __device__ __forceinline__ void operator()(const f32x4 (&acc)[2][2][4][2], const Unit& u, int wr, int wc, int fr, int fq) const {
        const int pn = u.pn; const int row0 = u.pm * BM + wr * 64 + fr;
        if (pn < 4) { float* base = LWA + (size_t)row0 * 1024 + pn * 256 + wc * 32 + 8 * fq;
#pragma unroll
            for (int ai = 0; ai < 2; ++ai)
#pragma unroll
                for (int m = 0; m < 4; ++m) { float* p = base + (size_t)(ai * HALF + m * 16) * 1024;
#pragma unroll
                    for (int bj = 0; bj < 2; ++bj) { *(f32x4*)(p + bj * HALF) = acc[ai][bj][m][0]; *(f32x4*)(p + bj * HALF + 4) = acc[ai][bj][m][1]; }
                    asm volatile("" ::: "memory"); }
        } else { bf16_t* base = LG + (size_t)row0 * 512 + (pn - 4) * 256 + wc * 32 + 8 * fq;
#pragma unroll
            for (int ai = 0; ai < 2; ++ai)
#pragma unroll
                for (int m = 0; m < 4; ++m) { bf16_t* p = base + (size_t)(ai * HALF + m * 16) * 512;
#pragma unroll
                    for (int bj = 0; bj < 2; ++bj) *(u32x4*)(p + bj * HALF) = pack8(acc[ai][bj][m][0], acc[ai][bj][m][1]);
                    asm volatile("" ::: "memory"); }
        }
    }
};
struct Epi2 {
    static constexpr bool PERM = true, AFTER_DRAIN = false;
    const bf16_t* GATE; float* MG; bf16_t* MERGED;
    __device__ __forceinline__ void operator()(const f32x4 (&acc)[2][2][4][2], const Unit& u, int wr, int wc, int fr, int fq) const {
        const int br = u.pn >> 2, pc = u.pn & 3; const int row0 = u.pm * BM + wr * 64 + fr; const int col0 = pc * 256 + wc * 32 + 8 * fq;
#pragma unroll
        for (int ai = 0; ai < 2; ++ai)
#pragma unroll
            for (int m = 0; m < 4; ++m) { const size_t row = (size_t)(row0 + ai * HALF + m * 16);
#pragma unroll
                for (int bj = 0; bj < 2; ++bj) { const int col = col0 + bj * HALF;
                    const u32x4 gw = *(const u32x4*)(GATE + row * 3072 + br * 1024 + col); f32x4 g0, g1; unpack8(gw, g0, g1);
                    f32x4 v0 = acc[ai][bj][m][0] * g0, v1 = acc[ai][bj][m][1] * g1; float* mp = MG + row * 1024 + col;
                    if (br > 0) { v0 += *(const f32x4*)mp; v1 += *(const f32x4*)(mp + 4); }
                    if (br < 2) { *(f32x4*)mp = v0; *(f32x4*)(mp + 4) = v1; }
                    else *(u32x4*)(MERGED + row * 1024 + col) = pack8(v0, v1); } }
    }
};
struct Epi3 {
    static constexpr bool PERM = true, AFTER_DRAIN = false;
    const float* H; float* U; float alpha;
    __device__ __forceinline__ void operator()(const f32x4 (&acc)[2][2][4][2], const Unit& u, int wr, int wc, int fr, int fq) const {
        const int row0 = u.pm * BM + wr * 64 + fr; const int col0 = u.pn * 256 + wc * 32 + 8 * fq;
#pragma unroll
        for (int ai = 0; ai < 2; ++ai)
#pragma unroll
            for (int m = 0; m < 4; ++m) { const size_t off = (size_t)(row0 + ai * HALF + m * 16) * 1024 + col0;
#pragma unroll
                for (int bj = 0; bj < 2; ++bj) { const float* hp = H + off + bj * HALF; float* up = U + off + bj * HALF;
                    const f32x4 h0 = *(const f32x4*)hp, h1 = *(const f32x4*)(hp + 4);
                    *(f32x4*)up = h0 * alpha + acc[ai][bj][m][0]; *(f32x4*)(up + 4) = h1 * alpha + acc[ai][bj][m][1]; } }
    }
};
struct Epi4 {
    static constexpr bool PERM = true, AFTER_DRAIN = false;
    bf16_t* ACT;
    __device__ __forceinline__ void operator()(const f32x4 (&acc)[2][2][4][2], const Unit& u, int wr, int wc, int fr, int fq) const {
        const int row0 = u.pm * BM + wr * 64 + fr; const int col0 = u.pn * 128 + wc * 32 + 8 * fq;
#pragma unroll
        for (int ai = 0; ai < 2; ++ai)
#pragma unroll
            for (int m = 0; m < 4; ++m) { f32x4 v0, v1;
#pragma unroll
                for (int j = 0; j < 4; ++j) { const float a0 = acc[ai][0][m][0][j], a1 = acc[ai][0][m][1][j];
                    v0[j] = a0 * sigmoidf_(a0) * acc[ai][1][m][0][j]; v1[j] = a1 * sigmoidf_(a1) * acc[ai][1][m][1][j]; }
                *(u32x4*)(ACT + (size_t)(row0 + ai * HALF + m * 16) * 2816 + col0) = pack8(v0, v1); }
    }
};
template <class Epi, class Sched, bool ALIGN_EPI = false, bool SP2 = false>
__device__ __forceinline__ void gemm_phase(PG8_LAS unsigned char* lds, const Gemm g, const Sched& S, const Epi& E) {
    int tid_o = threadIdx.x; asm volatile("" : "+v"(tid_o));
    const int tid = tid_o, wid = __builtin_amdgcn_readfirstlane(tid >> 6), lane = tid & 63, wr = wid >> 2, wc = wid & 3, fr = lane & 15, fq = lane >> 4;
    const int K = g.K, nt = K / BK;
    unsigned voffA[2], voffB[2];
#pragma unroll
    for (int i = 0; i < 2; ++i) { int R, C; stage_rc(tid * 16 + i * 8192, R, C); const int Rb = Epi::PERM ? ((R & ~31) + perm32(R & 31)) : R;
        voffA[i] = (unsigned)(R * g.lda + C) * 2u; voffB[i] = (unsigned)(Rb * K + C) * 2u; }
    const size_t kstep = (size_t)(BK * 2);
    const size_t hstep = (size_t)HALF * K * 2;
    const size_t tstep = 2 * hstep; const size_t hstepA = (size_t)HALF * g.lda * 2, tstepA = 2 * hstepA;
    const unsigned ldsw = (unsigned)wid * 1024u;
    const int aoff = lds_byte(wr * 64 + fr, fq * 8), boff = lds_byte(wc * 32 + fr, fq * 8);
#define PG8_SA(b, h) (((b) * 2 + (h)) * HTB)
#define PG8_SB(b, h) ((4 + (b) * 2 + (h)) * HTB)
#define PG8_STAGE(bufoff, gbase, voff) do { _Pragma("unroll") for (int _i = 0; _i < 2; ++_i) \
        __builtin_amdgcn_global_load_lds((const unsigned*)((const char*)(gbase) + (voff)[_i]), (PG8_LAS unsigned*)(lds + (bufoff) + ldsw + _i * 8192), 16, 0, 0); } while (0)
#define PG8_LDA(dst, b, h) do { _Pragma("unroll") for (int m = 0; m < 4; ++m) _Pragma("unroll") for (int k = 0; k < 2; ++k) dst[m][k] = *(const PG8_LAS bf16x8*)(lds + PG8_SA(b, h) + aoff + m * 2048 + k * 1024); } while (0)
#define PG8_LDB(dst, b, h) do { _Pragma("unroll") for (int n = 0; n < 2; ++n) _Pragma("unroll") for (int k = 0; k < 2; ++k) dst[n][k] = *(const PG8_LAS bf16x8*)(lds + PG8_SB(b, h) + boff + n * 2048 + k * 1024); } while (0)
#define PG8_MMA(ai, bj, At, Bt) do { __builtin_amdgcn_s_setprio(1); _Pragma("unroll") for (int m = 0; m < 4; ++m) _Pragma("unroll") for (int n = 0; n < 2; ++n) _Pragma("unroll") for (int k = 0; k < 2; ++k) \
        acc[ai][bj][m][n] = __builtin_amdgcn_mfma_f32_16x16x32_bf16(Bt[n][k], At[m][k], acc[ai][bj][m][n], 0, 0, 0); __builtin_amdgcn_s_setprio(0); } while (0)
#define PG8_WAIT_V(n) asm volatile("s_waitcnt vmcnt(" #n ")" ::: "memory")
#define PG8_WAIT_L(n) asm volatile("s_waitcnt lgkmcnt(" #n ")" ::: "memory")
#define PG8_BAR __builtin_amdgcn_s_barrier()
#define PG8_SCHED __builtin_amdgcn_sched_barrier(0)
    Unit cur, nxt; int ui = 0;
    if (!S.next(0, cur)) return;
    f32x4 acc[2][2][4][2];
#pragma unroll
    for (int a = 0; a < 2; ++a)
#pragma unroll
        for (int b = 0; b < 2; ++b)
#pragma unroll
            for (int m = 0; m < 4; ++m)
#pragma unroll
                for (int n = 0; n < 2; ++n) acc[a][b][m][n] = (f32x4){0.f, 0.f, 0.f, 0.f};
    bf16x8 At[4][2], B0[2][2], B1[2][2];
    const char* cA = (const char*)g.A + (size_t)cur.pm * tstepA + (size_t)cur.koff * 2; const char* cB = (const char*)g.Bt + (size_t)cur.pn * tstep;
    S.a_ready(cur);
    if constexpr (SP2) {
        PG8_STAGE(PG8_SB(0, 0), cB, voffB); PG8_STAGE(PG8_SB(0, 1), cB + hstep, voffB); PG8_STAGE(PG8_SA(0, 0), cA, voffA); PG8_STAGE(PG8_SA(0, 1), cA + hstepA, voffA);
        if (wr == 1) PG8_BAR;
        PG8_WAIT_V(2); PG8_BAR;
        PG8_STAGE(PG8_SB(1, 0), cB + kstep, voffB); PG8_STAGE(PG8_SA(1, 0), cA + kstep, voffA); PG8_STAGE(PG8_SB(1, 1), cB + hstep + kstep, voffB);
        PG8_WAIT_V(6); PG8_BAR;
    } else {
        PG8_STAGE(PG8_SB(0, 0), cB, voffB); PG8_STAGE(PG8_SA(0, 0), cA, voffA); PG8_STAGE(PG8_SB(0, 1), cB + hstep, voffB); PG8_STAGE(PG8_SA(0, 1), cA + hstepA, voffA);
        if (wr == 1) PG8_BAR;
        PG8_WAIT_V(4); PG8_BAR;
        PG8_STAGE(PG8_SB(1, 0), cB + kstep, voffB); PG8_STAGE(PG8_SA(1, 0), cA + kstep, voffA); PG8_STAGE(PG8_SB(1, 1), cB + hstep + kstep, voffB);
        PG8_WAIT_V(6); PG8_BAR;
    }
    for (;;) {
        const bool has_next = S.next(ui + 1, nxt);
        const char* nA = has_next ? (const char*)g.A + (size_t)nxt.pm * tstepA + (size_t)nxt.koff * 2 : cA; const char* nB = has_next ? (const char*)g.Bt + (size_t)nxt.pn * tstep : cB;
        for (int t = 0; t < nt; t += 2) {
            const bool last = (t == nt - 2);
            const char* a1 = cA + (size_t)(t + 1) * kstep;
            const char* a2 = last ? nA : cA + (size_t)(t + 2) * kstep; const char* b2 = last ? nB : cB + (size_t)(t + 2) * kstep;
            const char* a3 = a2 + kstep; const char* b3 = b2 + kstep;
            if (last && has_next) S.a_ready(nxt);
            if constexpr (SP2) {
            PG8_LDB(B0, 0, 0); PG8_LDB(B1, 0, 1); PG8_SCHED; PG8_LDA(At, 0, 0); PG8_STAGE(PG8_SA(1, 1), a1 + hstepA, voffA);
            PG8_WAIT_V(8); PG8_WAIT_L(0); PG8_BAR; PG8_MMA(0, 0, At, B0); PG8_MMA(0, 1, At, B1); PG8_BAR; PG8_SCHED;
            PG8_LDA(At, 0, 1); PG8_STAGE(PG8_SB(0, 0), b2, voffB); PG8_STAGE(PG8_SB(0, 1), b2 + hstep, voffB); PG8_STAGE(PG8_SA(0, 0), a2, voffA);
            PG8_WAIT_V(8); PG8_WAIT_L(0); PG8_BAR; PG8_MMA(1, 0, At, B0); PG8_MMA(1, 1, At, B1); PG8_BAR; PG8_SCHED;
            PG8_LDB(B0, 1, 0); PG8_LDB(B1, 1, 1); PG8_SCHED; PG8_LDA(At, 1, 0); PG8_STAGE(PG8_SA(0, 1), a2 + hstepA, voffA);
            PG8_WAIT_V(8); PG8_WAIT_L(0); PG8_BAR; PG8_MMA(0, 0, At, B0); PG8_MMA(0, 1, At, B1); PG8_BAR; PG8_SCHED;
            PG8_LDA(At, 1, 1); PG8_STAGE(PG8_SB(1, 0), b3, voffB); PG8_STAGE(PG8_SB(1, 1), b3 + hstep, voffB); PG8_STAGE(PG8_SA(1, 0), a3, voffA);
            PG8_WAIT_V(8); PG8_WAIT_L(0); PG8_BAR; PG8_MMA(1, 0, At, B0); PG8_MMA(1, 1, At, B1); PG8_BAR; PG8_SCHED;
            } else {
            PG8_LDB(B0, 0, 0); PG8_SCHED; PG8_LDA(At, 0, 0); PG8_STAGE(PG8_SA(1, 1), a1 + hstepA, voffA);
            PG8_WAIT_L(8); PG8_BAR; PG8_WAIT_L(0); PG8_MMA(0, 0, At, B0); PG8_BAR; PG8_SCHED;
            PG8_LDB(B1, 0, 1); PG8_STAGE(PG8_SB(0, 0), b2, voffB);
            PG8_BAR; PG8_WAIT_L(0); PG8_MMA(0, 1, At, B1); PG8_BAR;
            PG8_LDA(At, 0, 1); PG8_STAGE(PG8_SA(0, 0), a2, voffA);
            PG8_BAR; PG8_WAIT_L(0); PG8_MMA(1, 0, At, B0); PG8_BAR; PG8_SCHED;
            PG8_STAGE(PG8_SB(0, 1), b2 + hstep, voffB);
            PG8_WAIT_V(6); PG8_BAR; PG8_MMA(1, 1, At, B1); PG8_BAR;
            PG8_LDB(B0, 1, 0); PG8_SCHED; PG8_LDA(At, 1, 0); PG8_STAGE(PG8_SA(0, 1), a2 + hstepA, voffA);
            PG8_WAIT_L(8); PG8_BAR; PG8_WAIT_L(0); PG8_MMA(0, 0, At, B0); PG8_BAR; PG8_SCHED;
            PG8_LDB(B1, 1, 1); PG8_STAGE(PG8_SB(1, 0), b3, voffB);
            PG8_BAR; PG8_WAIT_L(0); PG8_MMA(0, 1, At, B1); PG8_BAR;
            PG8_LDA(At, 1, 1); PG8_STAGE(PG8_SA(1, 0), a3, voffA);
            PG8_BAR; PG8_WAIT_L(0); PG8_MMA(1, 0, At, B0); PG8_BAR; PG8_SCHED;
            PG8_STAGE(PG8_SB(1, 1), b3 + hstep, voffB);
            PG8_WAIT_V(6); PG8_BAR; PG8_MMA(1, 1, At, B1); PG8_BAR;
            }
        }
        if constexpr (ALIGN_EPI) { if (wr == 0) PG8_BAR; }
        if constexpr (!Epi::AFTER_DRAIN) { E(acc, cur, wr, wc, fr, fq); S.done(cur); }
        if (!has_next) break;
#pragma unroll
        for (int a = 0; a < 2; ++a)
#pragma unroll
            for (int b = 0; b < 2; ++b)
#pragma unroll
                for (int m = 0; m < 4; ++m)
#pragma unroll
                    for (int n = 0; n < 2; ++n) acc[a][b][m][n] = (f32x4){0.f, 0.f, 0.f, 0.f};
        cur = nxt; cA = nA; cB = nB; ++ui;
        if constexpr (ALIGN_EPI) { if (wr == 1) PG8_BAR; }
    }
    PG8_WAIT_V(0);
    if constexpr (!ALIGN_EPI) { if (wr == 0) PG8_BAR; }
    PG8_BAR;
    if constexpr (Epi::AFTER_DRAIN) { E.fused(acc, cur, wr, wc, fr, fq, lds, wid, lane); S.done(cur); }
#undef PG8_SA
#undef PG8_SB
#undef PG8_STAGE
#undef PG8_LDA
#undef PG8_LDB
#undef PG8_MMA
#undef PG8_WAIT_V
#undef PG8_WAIT_L
#undef PG8_BAR
#undef PG8_SCHED
}
}

typedef unsigned short bf16;
typedef short bf16x8 __attribute__((ext_vector_type(8)));
typedef float f32x4 __attribute__((ext_vector_type(4)));
typedef float f32x16 __attribute__((ext_vector_type(16)));
typedef unsigned v4u __attribute__((ext_vector_type(4)));
#define LAS __attribute__((address_space(3)))
constexpr int NB = 8, TS = 2048, M = NB * TS, D = 1024, DEPTH = 4, MIXW = 512, RWIN = 1792, INC = 8448, DFF = 2816;
constexpr float ALPHA = 1.681792830507429f;
constexpr float LN_EPS = 1e-5f, GN_EPS = 64e-5f, RMS_EPS = 1e-6f;
constexpr size_t MiB = 1u << 20;
constexpr size_t WS_WIN = 1 * MiB, WS_WUP = 18 * MiB, WS_WOUT = 21 * MiB, WS_WFI = 23 * MiB, WS_WFO = 34 * MiB, WS_WLORA = 40 * MiB, WS_BON = 41 * MiB;
constexpr size_t WS_H = 42 * MiB, WS_HB = 106 * MiB, WS_QK = 138 * MiB, WS_VT = 170 * MiB, WS_HG = 186 * MiB, WS_PRW = 250 * MiB, WS_GATE = 306 * MiB;
constexpr size_t WS_Y = 402 * MiB, WS_T = 450 * MiB, WS_LWA = 458 * MiB, WS_END = 522 * MiB;
constexpr size_t WS_LG = 138 * MiB, WS_YRAW = 154 * MiB, WS_MG = 138 * MiB, WS_MERGED = 202 * MiB, WS_U = 250 * MiB, WS_ACT = 314 * MiB;
constexpr int LDS_BYTES = 147456;
constexpr int NWAVES = 8;

struct Args { const float* in[25]; float* out; unsigned char* ws; };

__device__ __forceinline__ float bf2f(bf16 b) { return __uint_as_float((unsigned)b << 16); }
__device__ __forceinline__ bf16 f2bf(float f) { return (bf16)(pg8::cvt_pk_bf16(f, 0.f) & 0xffffu); }
__device__ __forceinline__ float sigm(float x) { return __builtin_amdgcn_rcpf(1.0f + __expf(-x)); }
__device__ __forceinline__ float wave_sum(float v) {
#pragma unroll
    for (int o = 1; o < 64; o <<= 1) v += __shfl_xor(v, o);
    return v;
}
template <int CTRL> __device__ __forceinline__ float dppf(float x) { return __builtin_bit_cast(float, __builtin_amdgcn_update_dpp(0, __builtin_bit_cast(int, x), CTRL, 0xF, 0xF, true)); }
__device__ __forceinline__ float row16_sum(float x) {
    x += dppf<0xB1>(x); x += dppf<0x4E>(x); x += dppf<0x141>(x); x += dppf<0x140>(x); return x;
}
#define LDS_WAIT() asm volatile("s_waitcnt lgkmcnt(0)" ::: "memory")

__device__ __forceinline__ void transpose_item(const float* W, int K, int N, bf16* WT, int k0, int n0, int drow0, LAS float* scr, int lane) {
#pragma unroll 8
    for (int i = 0; i < 32; ++i) { const int kk = 2 * i + (lane >> 5); scr[kk * 33 + (lane & 31)] = W[(size_t)(k0 + kk) * N + n0 + (lane & 31)]; }
    LDS_WAIT(); asm volatile("" ::: "memory");
    const int c = lane & 7;
#pragma unroll
    for (int j = 0; j < 4; ++j) { const int n = (lane >> 3) + 8 * j; const LAS float* s = scr + (8 * c) * 33 + n;
        v4u o; o.x = pg8::cvt_pk_bf16(s[0 * 33], s[1 * 33]); o.y = pg8::cvt_pk_bf16(s[2 * 33], s[3 * 33]); o.z = pg8::cvt_pk_bf16(s[4 * 33], s[5 * 33]); o.w = pg8::cvt_pk_bf16(s[6 * 33], s[7 * 33]);
        *(v4u*)(WT + (size_t)(drow0 + n) * K + k0 + 8 * c) = o; }
    LDS_WAIT(); asm volatile("" ::: "memory");
}
__device__ __forceinline__ void conv_weights(const Args& a, int l, LAS unsigned char* lds, int gw, int NGW, int wave, int lane) {
    unsigned char* ws = a.ws;
    LAS float* scr = (LAS float*)(lds + wave * 16384);
    const float* Win = a.in[3] + (size_t)l * D * INC; const float* Wup = a.in[17] + (size_t)l * 3 * MIXW * D; const float* Wout = a.in[18] + (size_t)l * D * D;
    const float* Wfi = a.in[21] + (size_t)l * D * 2 * DFF; const float* Wfo = a.in[22] + (size_t)l * DFF * D;
    constexpr int I_IN = (D / 64) * (INC / 32), I_UP = (MIXW / 64) * (D / 32), I_OUT = (D / 64) * (D / 32), I_FI = (D / 64) * (2 * DFF / 32), I_FO = (DFF / 64) * (D / 32);
    constexpr int NITEMS = I_IN + 3 * I_UP + I_OUT + I_FI + I_FO;
    for (int it = gw; it < NITEMS; it += NGW) {
        int r = it;
        if (r < I_IN) { const int nblk = INC / 32, kb = r / nblk, nb = r % nblk; transpose_item(Win, D, INC, (bf16*)(ws + WS_WIN), 64 * kb, 32 * nb, 32 * nb, scr, lane); continue; } r -= I_IN;
        if (r < 3 * I_UP) { const int br = r / I_UP; r -= br * I_UP; const int nblk = D / 32, kb = r / nblk, nb = r % nblk;
            transpose_item(Wup + (size_t)br * MIXW * D, MIXW, D, (bf16*)(ws + WS_WUP), 64 * kb, 32 * nb, br * D + 32 * nb, scr, lane); continue; } r -= 3 * I_UP;
        if (r < I_OUT) { const int nblk = D / 32, kb = r / nblk, nb = r % nblk; transpose_item(Wout, D, D, (bf16*)(ws + WS_WOUT), 64 * kb, 32 * nb, 32 * nb, scr, lane); continue; } r -= I_OUT;
        if (r < I_FI) { const int nblk = 2 * DFF / 32, kb = r / nblk, nb = r % nblk; const int n0 = 32 * nb; const int half = n0 >= DFF ? 1 : 0, nn = n0 - half * DFF;
            transpose_item(Wfi, D, 2 * DFF, (bf16*)(ws + WS_WFI), 64 * kb, n0, 256 * (nn >> 7) + 128 * half + (nn & 127), scr, lane); continue; } r -= I_FI;
        { const int nblk = D / 32, kb = r / nblk, nb = r % nblk; transpose_item(Wfo, DFF, D, (bf16*)(ws + WS_WFO), 64 * kb, 32 * nb, 32 * nb, scr, lane); }
    }
    const float* wu = a.in[6] + (size_t)l * 64 * MIXW; const float* au = a.in[8] + (size_t)l * 64 * MIXW; const float* gu = a.in[9] + (size_t)l * 128 * MIXW;
    bf16* WL = (bf16*)(ws + WS_WLORA);
    for (int idx = gw * 64 + lane; idx < 1536 * 256; idx += NGW * 64) { const int n = idx >> 8, k = idx & 255; float v = 0.f;
        if (n < 512) { if (k < 64) v = wu[k * MIXW + n]; } else if (n < 1024) { if (k >= 64 && k < 128) v = au[(k - 64) * MIXW + n - 512]; } else { if (k >= 128) v = gu[(k - 128) * MIXW + n - 1024]; }
        WL[idx] = f2bf(v); }
}
__device__ __forceinline__ void ln_rows(const float* src, const float* gam, const float* bet, float* dstf, bf16* dstb, int gw, int NGW, int lane) {
    for (int m = gw; m < M; m += NGW) {
        const f32x4* xr = (const f32x4*)(src + (size_t)m * D) + lane;
        f32x4 v[4]; float s = 0.f;
#pragma unroll
        for (int j = 0; j < 4; ++j) { v[j] = xr[64 * j]; s += (v[j].x + v[j].y) + (v[j].z + v[j].w); }
        const float mean = wave_sum(s) * (1.f / D); float s2 = 0.f;
#pragma unroll
        for (int j = 0; j < 4; ++j) { v[j] = v[j] - mean; s2 += (v[j].x * v[j].x + v[j].y * v[j].y) + (v[j].z * v[j].z + v[j].w * v[j].w); }
        const float rstd = 1.f / sqrtf(wave_sum(s2) * (1.f / D) + LN_EPS);
        f32x4* of = (f32x4*)(dstf + (size_t)m * D) + lane; unsigned long long* ob = (unsigned long long*)(dstb + (size_t)m * D) + lane;
#pragma unroll
        for (int j = 0; j < 4; ++j) { const f32x4 g = ((const f32x4*)gam)[lane + 64 * j], b = ((const f32x4*)bet)[lane + 64 * j]; const f32x4 o = v[j] * rstd * g + b;
            of[64 * j] = o; if (dstb) ob[64 * j] = (unsigned long long)pg8::cvt_pk_bf16(o.x, o.y) | ((unsigned long long)pg8::cvt_pk_bf16(o.z, o.w) << 32); }
    }
}
#define XB_TMO      128
#define XB_XCNT(j)  (256  + 64 * (j))
#define XB_XSUB(j)  (1280 + 64 * (j))
#define XB_XGEN(j)  (2304 + 64 * (j))
#define XB_TOP      3328
#define XB_TOPGEN   3392
#define XCD_BAR_WORDS 3456
#define XB_SPIN_CAP (1u << 18)

__device__ __forceinline__ unsigned xb_ld(unsigned* p)              { return __hip_atomic_load(p, __ATOMIC_RELAXED, __HIP_MEMORY_SCOPE_AGENT); }
__device__ __forceinline__ unsigned xb_add(unsigned* p, unsigned v) { return __hip_atomic_fetch_add(p, v, __ATOMIC_RELAXED, __HIP_MEMORY_SCOPE_AGENT); }
__device__ __forceinline__ unsigned xb_xcc_id() { return (unsigned)__builtin_amdgcn_s_getreg((3 << 11) | 20) & 0xFu; }
#define XB_SPIN(cond, bar) do { unsigned _sp = 0; while (cond) { __builtin_amdgcn_s_sleep(1); \
    if ((++_sp & 255u) == 0u) { if (xb_ld(&(bar)[XB_TMO])) break; if (_sp > XB_SPIN_CAP) { atomicAdd(&(bar)[XB_TMO], 1u); break; } } } } while (0)

struct XcdBarrier {
    unsigned* bar; unsigned x;
    volatile LAS unsigned* st;
};

__device__ __forceinline__ XcdBarrier xcd_barrier_post(unsigned* bar, volatile LAS unsigned* st) {
    XcdBarrier b; b.bar = bar; b.x = xb_xcc_id(); b.st = st;
    if (threadIdx.x == 0) (void)xb_add(&bar[XB_XCNT(b.x)], 1u);
    return b;
}
__device__ __forceinline__ void xcd_barrier_complete(unsigned* bar, unsigned x, unsigned& nloc, unsigned& nx) {
    const unsigned G = gridDim.x * gridDim.y * gridDim.z;
    unsigned sum, cnt, mine, sp = 0u;
    for (;;) {
        sum = 0u; cnt = 0u; mine = 0u;
#pragma unroll
        for (unsigned j = 0; j < 16; ++j) { const unsigned c = xb_ld(&bar[XB_XCNT(j)]); sum += c; cnt += (c > 0u) ? 1u : 0u; mine = (j == x) ? c : mine; }
        if (sum == G) break;
        __builtin_amdgcn_s_sleep(1);
        if ((++sp & 255u) == 0u) { if (xb_ld(&bar[XB_TMO])) break; if (sp > XB_SPIN_CAP) { atomicAdd(&bar[XB_TMO], 1u); break; } }
    }
    nloc = mine > 0u ? mine : 1u; nx = cnt > 0u ? cnt : 1u;
}

__device__ __forceinline__ void xcd_barrier(const XcdBarrier& b) {
    asm volatile("s_waitcnt vmcnt(0)" ::: "memory");
    __syncthreads();
    if (threadIdx.x == 0) {
        unsigned* bar = b.bar;
        __builtin_amdgcn_s_waitcnt(0);
        unsigned nloc = b.st[0], nx = b.st[1];
        if (nloc == 0u) { xcd_barrier_complete(bar, b.x, nloc, nx); b.st[0] = nloc; b.st[1] = nx; }
        const unsigned old = xb_add(&bar[XB_XSUB(b.x)], 1u);
        const unsigned gen = old / nloc;
        if (old + 1u == (gen + 1u) * nloc) {
            __builtin_amdgcn_fence(__ATOMIC_RELEASE, "agent");
            asm volatile("s_waitcnt vmcnt(0)" ::: "memory");
            const unsigned og = xb_add(&bar[XB_TOP], 1u);
            const unsigned tg = og / nx;
            if (og + 1u == (tg + 1u) * nx) xb_add(&bar[XB_TOPGEN], 1u);
            else XB_SPIN(xb_ld(&bar[XB_TOPGEN]) == tg, bar);
            __builtin_amdgcn_fence(__ATOMIC_ACQUIRE, "agent");
            xb_add(&bar[XB_XGEN(b.x)], 1u);
            asm volatile("s_waitcnt vmcnt(0)" ::: "memory");
        } else {
            XB_SPIN(xb_ld(&bar[XB_XGEN(b.x)]) == gen, bar);
            __builtin_amdgcn_fence(__ATOMIC_ACQUIRE, "agent");
            asm volatile("s_waitcnt vmcnt(0)" ::: "memory");
        }
    }
    __syncthreads();
}
__device__ __forceinline__ void prep_lora_in(const Args& a, int l, int gtid, int NT) {
    const bf16* PRW = (const bf16*)(a.ws + WS_PRW); bf16* T = (bf16*)(a.ws + WS_T); const float* mu = a.in[4] + (size_t)l * RWIN + 1536;
    for (int idx = gtid; idx < M * 256; idx += NT) { const int t = idx >> 8, c = idx & 255; const bf16* p = PRW + (size_t)t * RWIN + 1536 + c;
        const float x = bf2f(p[0]); const float xp = (t & (TS - 1)) ? bf2f(p[-RWIN]) : 0.f; const float v = x + (xp - x) * mu[c];
        float o; if (c < 64) o = 1.f - 2.f * __builtin_amdgcn_rcpf(1.f + __expf(2.f * v)); else if (c < 128) o = v; else o = sigm(v);
        T[idx] = f2bf(o); }
}
__device__ __forceinline__ void hgrn_scan(const Args& a, int l, int u, LAS unsigned char* lds, int tid) {
    const int b = u >> 5, h = (u >> 3) & 3, vq = u & 7;
    const bf16* HG = (const bf16*)(a.ws + WS_HG); bf16* Y = (bf16*)(a.ws + WS_Y);
    LAS float* buf0 = (LAS float*)lds; LAS float* ob0 = (LAS float*)(lds + 102400);
    const bool prod = tid >= 256; const int ptid = tid & 255;
    float lb = 0.f; const int ch = ptid & 127;
    if (prod) { const float* lg = a.in[15] + h * 128 + ch; const float l0 = lg[0], l1 = lg[MIXW], l2 = lg[2 * MIXW], l3 = lg[3 * MIXW];
        const float mx = fmaxf(fmaxf(l0, l1), fmaxf(l2, l3)); const float e0 = __expf(l0 - mx), e1 = __expf(l1 - mx), e2 = __expf(l2 - mx), e3 = __expf(l3 - mx);
        const float num = (l >= 1 ? e1 : 0.f) + (l >= 2 ? e2 : 0.f) + (l >= 3 ? e3 : 0.f); lb = num / (e0 + e1 + e2 + e3); }
    const int vr = ptid >> 4, kq = ptid & 15;
    f32x4 S0 = {0.f, 0.f, 0.f, 0.f}, S1 = {0.f, 0.f, 0.f, 0.f};
    bf16 rq[16], rf[16], ri[2];
    const bf16* pq = HG + ((size_t)b * TS + (ptid >> 7)) * 2048 + h * 128 + ch;
    const bf16* pi = HG + ((size_t)b * TS + (ptid >> 4)) * 2048 + 1024 + h * 128 + vq * 16 + (ptid & 15);
#define HG_LOAD(cn) do { const size_t ro = (size_t)(cn) * 32 * 2048; _Pragma("unroll") for (int j = 0; j < 16; ++j) { rq[j] = pq[ro + (size_t)j * 2 * 2048]; rf[j] = pq[ro + (size_t)j * 2 * 2048 + 512]; } \
        _Pragma("unroll") for (int j = 0; j < 2; ++j) ri[j] = pi[ro + (size_t)j * 16 * 2048]; } while (0)
    if (prod) HG_LOAD(0);
    __syncthreads();
#pragma unroll 1
    for (int c = -1; c < TS / 32; ++c) {
        if (prod) {
            if (c + 1 < TS / 32) { LAS float* bp = buf0 + ((c + 1) & 1) * 12800;
#pragma unroll
                for (int j = 0; j < 16; ++j) { const int tt = (ptid >> 7) + 2 * j; const float q = bf2f(rq[j]), f = bf2f(rf[j]); const float fg = lb + (1.f - lb) * sigm(f);
                    bp[tt * 400 + ch] = fg; bp[tt * 400 + 128 + ch] = 1.f - fg; bp[tt * 400 + 256 + ch] = q; }
#pragma unroll
                for (int j = 0; j < 2; ++j) { const int tt = (ptid >> 4) + 16 * j; const float iv = bf2f(ri[j]); bp[tt * 400 + 384 + (ptid & 15)] = iv * sigm(iv); }
                if (c + 2 < TS / 32) HG_LOAD(c + 2); }
            if (c >= 1) { const LAS float* op = ob0 + ((c - 1) & 1) * 512; const size_t t0 = (size_t)b * TS + (size_t)(c - 1) * 32;
#pragma unroll
                for (int j = 0; j < 2; ++j) { const int idx = ptid + 256 * j, tt = idx >> 4, vc = idx & 15; Y[(t0 + tt) * 1536 + 1024 + h * 128 + vq * 16 + vc] = f2bf(op[idx]); } }
        } else if (c >= 0) {
            const LAS float* bp = buf0 + (c & 1) * 12800 + 8 * kq; LAS float* op = ob0 + (c & 1) * 512;
            f32x4 f0 = *(const LAS f32x4*)bp, f1 = *(const LAS f32x4*)(bp + 4), k0 = *(const LAS f32x4*)(bp + 128), k1 = *(const LAS f32x4*)(bp + 132), q0 = *(const LAS f32x4*)(bp + 256), q1 = *(const LAS f32x4*)(bp + 260);
            float v = bp[384 - 8 * kq + vr];
#pragma unroll 4
            for (int tt = 0; tt < 32; ++tt) { const LAS float* p = bp + (tt < 31 ? tt + 1 : tt) * 400;
                const f32x4 nf0 = *(const LAS f32x4*)p, nf1 = *(const LAS f32x4*)(p + 4), nk0 = *(const LAS f32x4*)(p + 128), nk1 = *(const LAS f32x4*)(p + 132), nq0 = *(const LAS f32x4*)(p + 256), nq1 = *(const LAS f32x4*)(p + 260);
                const float nv = p[384 - 8 * kq + vr];
                S0 = f0 * S0 + k0 * v; S1 = f1 * S1 + k1 * v;
                const f32x4 pr = S0 * q0 + S1 * q1; const float o = row16_sum((pr.x + pr.y) + (pr.z + pr.w));
                if (kq == 0) op[tt * 16 + vr] = o;
                f0 = nf0; f1 = nf1; k0 = nk0; k1 = nk1; q0 = nq0; q1 = nq1; v = nv; }
        }
        __syncthreads();
    }
#undef HG_LOAD
    if (prod) { const LAS float* op = ob0 + ((TS / 32 - 1) & 1) * 512; const size_t t0 = (size_t)b * TS + (size_t)(TS / 32 - 1) * 32;
#pragma unroll
        for (int j = 0; j < 2; ++j) { const int idx = ptid + 256 * j, tt = idx >> 4, vc = idx & 15; Y[(t0 + tt) * 1536 + 1024 + h * 128 + vq * 16 + vc] = f2bf(op[idx]); } }
    __syncthreads();
}
__device__ __forceinline__ void rwkv_scan(const Args& a, int l, int u, LAS unsigned char* lds, int tid) {
    const int b = u >> 5, h = (u >> 2) & 7, qt = u & 3;
    const bf16* PRW = (const bf16*)(a.ws + WS_PRW); const float* LWA = (const float*)(a.ws + WS_LWA); float* YRAW = (float*)(a.ws + WS_YRAW); float* BON = (float*)(a.ws + WS_BON);
    LAS float* buf0 = (LAS float*)lds; LAS float* ob0 = (LAS float*)(lds + 86016);
    const bool prod = tid >= 256; const int ptid = tid & 255; const int lane = tid & 63;
    const int ch = ptid & 63, cc = h * 64 + ch;
    float mu_r = 0.f, mu_k = 0.f, mu_v = 0.f, w0 = 0.f, a0 = 0.f, kkc = 0.f, kac = 0.f, rkc = 0.f;
    if (prod) { const float* mu = a.in[4] + (size_t)l * RWIN; mu_r = mu[cc]; mu_k = mu[512 + cc]; mu_v = mu[1024 + cc];
        w0 = a.in[5][l * MIXW + cc]; a0 = a.in[7][l * MIXW + cc]; kkc = a.in[10][l * MIXW + cc]; kac = a.in[11][l * MIXW + cc]; rkc = a.in[12][l * MIXW + cc]; }
    const int vr = ptid >> 4, kq = ptid & 15;
    f32x4 S = {0.f, 0.f, 0.f, 0.f};
    bf16 xr[8], xrp[8], xk[8], xkp[8], xv[8], xvp[8]; float xlw[8], xla[8];
    const size_t trow = (size_t)b * TS + (ptid >> 6);
    const bf16* pr_ = PRW + trow * RWIN + cc; const float* pl_ = LWA + trow * 1024 + cc;
#define RW_LOAD(cn) do { _Pragma("unroll") for (int j = 0; j < 8; ++j) { const size_t ro = (size_t)((cn) * 32 + 4 * j); const bf16* row = pr_ + ro * RWIN; \
        xr[j] = row[0]; xk[j] = row[512]; xv[j] = row[1024]; xrp[j] = row[-RWIN]; xkp[j] = row[512 - RWIN]; xvp[j] = row[1024 - RWIN]; xlw[j] = pl_[ro * 1024]; xla[j] = pl_[ro * 1024 + 512]; } } while (0)
    if (prod) RW_LOAD(0);
    __syncthreads();
#pragma unroll 1
    for (int c = -1; c < TS / 32; ++c) {
        if (prod) {
            if (c + 1 < TS / 32) { LAS float* bp = buf0 + ((c + 1) & 1) * 10752; const size_t t0 = (size_t)b * TS + (size_t)(c + 1) * 32;
#pragma unroll
                for (int j = 0; j < 8; ++j) { const int tt = (ptid >> 6) + 4 * j; const size_t t = t0 + tt; const bool first = ((c + 1) * 32 + tt) == 0;
                    float r = bf2f(xr[j]), k = bf2f(xk[j]), v = bf2f(xv[j]);
                    const float rp = first ? 0.f : bf2f(xrp[j]), kp_ = first ? 0.f : bf2f(xkp[j]), vp = first ? 0.f : bf2f(xvp[j]);
                    r += (rp - r) * mu_r; k += (kp_ - k) * mu_k; v += (vp - v) * mu_v;
                    const float x = w0 + xlw[j]; const float sp = fmaxf(-x, 0.f) + __logf(1.f + __expf(-fabsf(x))); const float dec = __expf(-__expf(-sp - 0.5f));
                    const float av = sigm(a0 + xla[j]);
                    float kk = k * kkc; const float ss = wave_sum(kk * kk); kk *= rsqrtf(fmaxf(ss, 1e-24f));
                    const float kp = k * (1.f + (av - 1.f) * kac);
                    const float bon = wave_sum(r * kp * rkc); if (qt == 0 && lane == 0) BON[t * 8 + h] = bon;
                    LAS float* rec = bp + tt * 336; rec[ch] = kk; rec[64 + ch] = dec; rec[128 + ch] = kk * av; rec[192 + ch] = kp; rec[256 + ch] = r;
                    if ((ch >> 4) == qt) rec[320 + (ch & 15)] = v; }
                if (c + 2 < TS / 32) RW_LOAD(c + 2); }
            if (c >= 1) { const LAS float* op = ob0 + ((c - 1) & 1) * 512; const size_t t0 = (size_t)b * TS + (size_t)(c - 1) * 32;
#pragma unroll
                for (int j = 0; j < 2; ++j) { const int idx = ptid + 256 * j, tt = idx >> 4, vc = idx & 15; YRAW[(t0 + tt) * MIXW + h * 64 + qt * 16 + vc] = op[idx]; } }
        } else if (c >= 0) {
            const LAS float* bp = buf0 + (c & 1) * 10752 + 4 * kq; LAS float* op = ob0 + (c & 1) * 512;
            f32x4 kk4 = *(const LAS f32x4*)bp, w4 = *(const LAS f32x4*)(bp + 64), ka4 = *(const LAS f32x4*)(bp + 128), kp4 = *(const LAS f32x4*)(bp + 192), r4 = *(const LAS f32x4*)(bp + 256);
            float v = bp[320 - 4 * kq + vr];
#pragma unroll 4
            for (int tt = 0; tt < 32; ++tt) { const LAS float* p = bp + (tt < 31 ? tt + 1 : tt) * 336;
                const f32x4 nkk4 = *(const LAS f32x4*)p, nw4 = *(const LAS f32x4*)(p + 64), nka4 = *(const LAS f32x4*)(p + 128), nkp4 = *(const LAS f32x4*)(p + 192), nr4 = *(const LAS f32x4*)(p + 256);
                const float nv = p[320 - 4 * kq + vr];
                const f32x4 d1 = S * kk4; const float sa = row16_sum((d1.x + d1.y) + (d1.z + d1.w));
                S = S * w4 + (kp4 * v - ka4 * sa);
                const f32x4 d2 = S * r4; const float y = row16_sum((d2.x + d2.y) + (d2.z + d2.w));
                if (kq == 0) op[tt * 16 + vr] = y;
                kk4 = nkk4; w4 = nw4; ka4 = nka4; kp4 = nkp4; r4 = nr4; v = nv; }
        }
        __syncthreads();
    }
#undef RW_LOAD
    if (prod) { const LAS float* op = ob0 + ((TS / 32 - 1) & 1) * 512; const size_t t0 = (size_t)b * TS + (size_t)(TS / 32 - 1) * 32;
#pragma unroll
        for (int j = 0; j < 2; ++j) { const int idx = ptid + 256 * j, tt = idx >> 4, vc = idx & 15; YRAW[(t0 + tt) * MIXW + h * 64 + qt * 16 + vc] = op[idx]; } }
    __syncthreads();
}
__device__ __forceinline__ void sb_attn_unit(const bf16* QK, const bf16* VT, bf16* Y, int b, int h, int qb, int lane) {
    const int ql = lane & 31, hi = lane >> 5; const int q0 = qb * 32;
    const bf16* qp = QK + ((size_t)(b * TS + q0 + ql) * 1024 + h * 64 + 8 * hi);
    bf16x8 qf[4];
#pragma unroll
    for (int ks = 0; ks < 4; ++ks) qf[ks] = *(const bf16x8*)(qp + 16 * ks);
    const int kperm = 16 * ((ql >> 2) & 1) + 4 * (ql >> 3) + (ql & 3);
    const bf16* kbase = QK + ((size_t)(b * TS + kperm) * 1024 + 512 + h * 64 + 8 * hi);
    const bf16* vbase = VT + ((size_t)((b * 8 + h) * 64 + ql)) * TS + 16 * hi;
    f32x16 o0, o1;
#pragma unroll
    for (int i = 0; i < 16; ++i) { o0[i] = 0.f; o1[i] = 0.f; }
    float carry = 0.f;
    bf16x8 kf[4];
#pragma unroll
    for (int ks = 0; ks < 4; ++ks) kf[ks] = *(const bf16x8*)(kbase + (size_t)q0 * 1024 + 16 * ks);
#pragma unroll 1
    for (int st = qb; st >= 0; --st) {
        const int k0 = st * 32;
        bf16x8 vb[4];
#pragma unroll
        for (int mm = 0; mm < 2; ++mm) { vb[2 * mm] = *(const bf16x8*)(vbase + k0 + 8 * mm); vb[2 * mm + 1] = *(const bf16x8*)(vbase + (size_t)32 * TS + k0 + 8 * mm); }
        f32x16 s;
#pragma unroll
        for (int i = 0; i < 16; ++i) s[i] = 0.f;
#pragma unroll
        for (int ks = 0; ks < 4; ++ks) s = __builtin_amdgcn_mfma_f32_32x32x16_bf16(kf[ks], qf[ks], s, 0, 0, 0);
        if (st > 0) {
#pragma unroll
            for (int ks = 0; ks < 4; ++ks) kf[ks] = *(const bf16x8*)(kbase + (size_t)(k0 - 32) * 1024 + 16 * ks);
        }
        const bool diag = (st == qb);
        float lk[16], zl[16]; float tot = 0.f;
#pragma unroll
        for (int i = 0; i < 16; ++i) { const float z = s[i] * 0.125f; const float sp = fmaxf(z, 0.f) + __logf(1.f + __expf(-fabsf(z)));
            const bool ok = !diag || (16 * hi + i < ql); lk[i] = ok ? -sp : 0.f; zl[i] = ok ? z - sp : -1e30f; tot += lk[i]; }
        const float other = __shfl_xor(tot, 32);
        float run = carry + (hi ? 0.f : other);
        float w[16];
#pragma unroll
        for (int i = 15; i >= 0; --i) { w[i] = __expf(zl[i] + run); run += lk[i]; }
        carry += tot + other;
#pragma unroll
        for (int mm = 0; mm < 2; ++mm) {
            v4u pk; pk.x = pg8::cvt_pk_bf16(w[8 * mm], w[8 * mm + 1]); pk.y = pg8::cvt_pk_bf16(w[8 * mm + 2], w[8 * mm + 3]); pk.z = pg8::cvt_pk_bf16(w[8 * mm + 4], w[8 * mm + 5]); pk.w = pg8::cvt_pk_bf16(w[8 * mm + 6], w[8 * mm + 7]);
            const bf16x8 pa = __builtin_bit_cast(bf16x8, pk);
            o0 = __builtin_amdgcn_mfma_f32_32x32x16_bf16(pa, vb[2 * mm], o0, 0, 0, 0);
            o1 = __builtin_amdgcn_mfma_f32_32x32x16_bf16(pa, vb[2 * mm + 1], o1, 0, 0, 0);
        }
        if (!__any(carry > -80.f)) break;
    }
    bf16* yp = Y + (size_t)(b * TS + q0 + 4 * hi) * 1536 + h * 64 + ql;
#pragma unroll
    for (int i = 0; i < 16; ++i) { const int row = (i & 3) + 8 * (i >> 2); yp[(size_t)row * 1536] = f2bf(o0[i]); yp[(size_t)row * 1536 + 32] = f2bf(o1[i]); }
}
__device__ __forceinline__ void post_mix(const Args& a, int l, int gw, int NGW, int lane) {
    const bf16* PRW = (const bf16*)(a.ws + WS_PRW); const float* YRAW = (const float*)(a.ws + WS_YRAW); const float* BON = (const float*)(a.ws + WS_BON);
    const bf16* LG = (const bf16*)(a.ws + WS_LG); const bf16* HG = (const bf16*)(a.ws + WS_HG); bf16* Y = (bf16*)(a.ws + WS_Y);
    const int c = 8 * lane;
    const float* mu = a.in[4] + (size_t)l * RWIN + 1024 + c; const float* gg = a.in[13] + l * MIXW + c; const float* gb = a.in[14] + l * MIXW + c; const float* ng = a.in[16] + l * MIXW + c;
    const f32x4 mu0 = *(const f32x4*)mu, mu1 = *(const f32x4*)(mu + 4), gg0 = *(const f32x4*)gg, gg1 = *(const f32x4*)(gg + 4), gb0 = *(const f32x4*)gb, gb1 = *(const f32x4*)(gb + 4), ng0 = *(const f32x4*)ng, ng1 = *(const f32x4*)(ng + 4);
    for (int t = gw; t < M; t += NGW) {
        {
            f32x4 y0 = *(const f32x4*)(YRAW + (size_t)t * MIXW + c), y1 = *(const f32x4*)(YRAW + (size_t)t * MIXW + c + 4);
            float s = (y0.x + y0.y) + (y0.z + y0.w) + (y1.x + y1.y) + (y1.z + y1.w); s += __shfl_xor(s, 1); s += __shfl_xor(s, 2); s += __shfl_xor(s, 4);
            const float mean = s * (1.f / 64.f); y0 = y0 - mean; y1 = y1 - mean;
            float q = (y0.x * y0.x + y0.y * y0.y) + (y0.z * y0.z + y0.w * y0.w) + (y1.x * y1.x + y1.y * y1.y) + (y1.z * y1.z + y1.w * y1.w); q += __shfl_xor(q, 1); q += __shfl_xor(q, 2); q += __shfl_xor(q, 4);
            const float rstd = rsqrtf(q * (1.f / 64.f) + GN_EPS);
            f32x4 v0, v1, p0, p1; pg8::unpack8(*(const v4u*)(PRW + (size_t)t * RWIN + 1024 + c), v0, v1);
            if (t & (TS - 1)) pg8::unpack8(*(const v4u*)(PRW + (size_t)(t - 1) * RWIN + 1024 + c), p0, p1); else { p0 = (f32x4){0.f, 0.f, 0.f, 0.f}; p1 = p0; }
            v0 = v0 + (p0 - v0) * mu0; v1 = v1 + (p1 - v1) * mu1;
            const float bon = BON[(size_t)t * 8 + (lane >> 3)];
            f32x4 g0, g1; pg8::unpack8(*(const v4u*)(LG + (size_t)t * MIXW + c), g0, g1);
            const f32x4 r0 = ((y0 * rstd * gg0 + gb0) + v0 * bon) * g0, r1 = ((y1 * rstd * gg1 + gb1) + v1 * bon) * g1;
            *(v4u*)(Y + (size_t)t * 1536 + 512 + c) = pg8::pack8(r0, r1);
        }
        {
            f32x4 o0, o1; pg8::unpack8(*(const v4u*)(Y + (size_t)t * 1536 + 1024 + c), o0, o1);
            float q = (o0.x * o0.x + o0.y * o0.y) + (o0.z * o0.z + o0.w * o0.w) + (o1.x * o1.x + o1.y * o1.y) + (o1.z * o1.z + o1.w * o1.w);
            q += __shfl_xor(q, 1); q += __shfl_xor(q, 2); q += __shfl_xor(q, 4); q += __shfl_xor(q, 8);
            const float rs = rsqrtf(q * (1.f / 128.f) + RMS_EPS);
            f32x4 h0, h1; pg8::unpack8(*(const v4u*)(HG + (size_t)t * 2048 + 1536 + c), h0, h1);
#pragma unroll
            for (int j = 0; j < 4; ++j) { h0[j] = h0[j] * sigm(h0[j]); h1[j] = h1[j] * sigm(h1[j]); }
            const f32x4 r0 = o0 * rs * ng0 * h0, r1 = o1 * rs * ng1 * h1;
            *(v4u*)(Y + (size_t)t * 1536 + 1024 + c) = pg8::pack8(r0, r1);
        }
    }
}
#ifndef REP_A
#define REP_A 1
#endif
#ifndef REP_HG
#define REP_HG 1
#endif
#ifndef REP_AT
#define REP_AT 1
#endif
#ifndef REP_B3
#define REP_B3 1
#endif
#ifndef REP_SYNC
#define REP_SYNC 1
#endif
#ifndef REP_CDFG
#define REP_CDFG 1
#endif
__global__ void __launch_bounds__(NWAVES * 64, 2) mk_fwd(Args a_unused) {
    extern __shared__ __attribute__((aligned(16))) unsigned char lds_raw[];
    LAS unsigned char* lds = (LAS unsigned char*)lds_raw;
    cg::grid_group grid = cg::this_grid();
    volatile LAS unsigned* bst = (volatile LAS unsigned*)(lds + LDS_BYTES - 64);
    if (threadIdx.x < 2) bst[threadIdx.x] = 0u;
    __syncthreads();
    { typedef const __attribute__((address_space(4))) Args* KA0; KA0 k0 = (KA0)__builtin_amdgcn_kernarg_segment_ptr(); (void)xcd_barrier_post((unsigned*)k0->ws, bst); }
#define GRID_BAR() do { typedef const __attribute__((address_space(4))) Args* KA1; KA1 k1 = (KA1)__builtin_amdgcn_kernarg_segment_ptr(); asm volatile("" : "+s"(k1)); \
        XcdBarrier xb_; xb_.bar = (unsigned*)k1->ws; xb_.x = xb_xcc_id(); xb_.st = bst; xcd_barrier(xb_); } while (0)
    typedef const __attribute__((address_space(4))) Args* KArgs;
#define PHASE_IDS() int tid = threadIdx.x; asm volatile("" : "+v"(tid)); const int lane = tid & 63, wave = __builtin_amdgcn_readfirstlane(tid >> 6); \
    int G = gridDim.x, bid = blockIdx.x; asm volatile("" : "+s"(G), "+s"(bid)); const int gw = bid * NWAVES + wave, NGW = G * NWAVES; \
    KArgs ka = (KArgs)__builtin_amdgcn_kernarg_segment_ptr(); asm volatile("" : "+s"(ka)); const Args a = *(const Args*)ka; unsigned char* ws = a.ws; \
    float* Hf = (float*)(ws + WS_H); bf16* Hb = (bf16*)(ws + WS_HB); float* U = (float*)(ws + WS_U); (void)lane; (void)gw; (void)NGW; (void)Hf; (void)Hb; (void)U; (void)tid

    { PHASE_IDS(); ln_rows(a.in[0], a.in[1], a.in[2], Hf, Hb, gw, NGW, lane);
    conv_weights(a, 0, lds, gw, NGW, wave, lane); }
    grid.sync();

#pragma unroll 1
    for (int l = 0; l < DEPTH; ++l) {
#ifndef SKIP_PA
        { PHASE_IDS();
        { pg8::Gemm g{Hb, (const bf16*)(ws + WS_WIN), M, INC, D, D}; pg8::StaticOrder S; S.init(M, INC, G, bid);
          pg8::Epi1 E{(bf16*)(ws + WS_QK), (bf16*)(ws + WS_VT), (bf16*)(ws + WS_PRW), (bf16*)(ws + WS_HG), (bf16*)(ws + WS_GATE)};
          for (int rep = 0; rep < REP_A; ++rep) pg8::gemm_phase<pg8::Epi1, pg8::StaticOrder, true, true>(lds, g, S, E); }
        }
#endif
        GRID_BAR();
        for (int rep = 1; rep < REP_SYNC; ++rep) GRID_BAR();
#ifndef SKIP_PB1
        { PHASE_IDS();
        prep_lora_in(a, l, bid * (NWAVES * 64) + tid, G * NWAVES * 64);
        for (int rep = 0; rep < REP_HG; ++rep) for (int u = bid; u < 256; u += G) hgrn_scan(a, l, u, lds, tid);
        for (int rep = 0; rep < REP_AT; ++rep) for (int wu = gw; wu < 4096; wu += NGW) { const int bh = wu & 63, qb = 63 - (wu >> 6); sb_attn_unit((const bf16*)(ws + WS_QK), (const bf16*)(ws + WS_VT), (bf16*)(ws + WS_Y), bh >> 3, bh & 7, qb, lane); }
        }
#endif
        GRID_BAR();
#ifndef SKIP_PB2
        { PHASE_IDS();
        { int Kl = 256; asm volatile("" : "+s"(Kl));
          pg8::Gemm g{(const bf16*)(ws + WS_T), (const bf16*)(ws + WS_WLORA), M, 1536, Kl, Kl}; pg8::StaticOrder S; S.init(M, 1536, G, bid);
          pg8::EpiLora E{(float*)(ws + WS_LWA), (bf16*)(ws + WS_LG)};
          pg8::gemm_phase<pg8::EpiLora, pg8::StaticOrder, true, true>(lds, g, S, E); }
        }
#endif
        GRID_BAR();
#ifndef SKIP_PB3
        { PHASE_IDS();
        for (int rep = 0; rep < REP_B3; ++rep) for (int u = bid; u < 256; u += G) rwkv_scan(a, l, u, lds, tid);
        }
#endif
        GRID_BAR();
#ifndef SKIP_PB4
        { PHASE_IDS();
        post_mix(a, l, gw, NGW, lane);
        }
#endif
        GRID_BAR();
#ifndef SKIP_PC
        { PHASE_IDS();
        { pg8::Gemm g{(const bf16*)(ws + WS_Y), (const bf16*)(ws + WS_WUP), M, 3072, 512, 1536}; pg8::BranchOrder S{G, bid};
          pg8::Epi2 E{(const bf16*)(ws + WS_GATE), (float*)(ws + WS_MG), (bf16*)(ws + WS_MERGED)};
          for (int rep = 0; rep < REP_CDFG; ++rep) pg8::gemm_phase<pg8::Epi2, pg8::BranchOrder, true, true>(lds, g, S, E); }
        }
#endif
        GRID_BAR();
#ifndef SKIP_PD
        { PHASE_IDS();
        { pg8::Gemm g{(const bf16*)(ws + WS_MERGED), (const bf16*)(ws + WS_WOUT), M, D, D, D}; pg8::StaticOrder S; S.init(M, D, G, bid);
          pg8::Epi3 E{Hf, U, ALPHA};
          for (int rep = 0; rep < REP_CDFG; ++rep) pg8::gemm_phase<pg8::Epi3, pg8::StaticOrder, true, true>(lds, g, S, E); }
        }
#endif
        GRID_BAR();
#ifndef SKIP_PE
        { PHASE_IDS();
        ln_rows(U, a.in[19] + l * D, a.in[20] + l * D, Hf, Hb, gw, NGW, lane);
        }
#endif
        GRID_BAR();
#ifndef SKIP_PF
        { PHASE_IDS();
        { pg8::Gemm g{Hb, (const bf16*)(ws + WS_WFI), M, 2 * DFF, D, D}; pg8::StaticOrder S; S.init(M, 2 * DFF, G, bid);
          pg8::Epi4 E{(bf16*)(ws + WS_ACT)};
          for (int rep = 0; rep < REP_CDFG; ++rep) pg8::gemm_phase<pg8::Epi4, pg8::StaticOrder, true, true>(lds, g, S, E); }
        }
#endif
        GRID_BAR();
#ifndef SKIP_PG
        { PHASE_IDS();
        { pg8::Gemm g{(const bf16*)(ws + WS_ACT), (const bf16*)(ws + WS_WFO), M, D, DFF, DFF}; pg8::StaticOrder S; S.init(M, D, G, bid);
          pg8::Epi3 E{Hf, U, ALPHA};
          for (int rep = 0; rep < REP_CDFG; ++rep) pg8::gemm_phase<pg8::Epi3, pg8::StaticOrder, true, true>(lds, g, S, E); }
        }
#endif
        GRID_BAR();
#ifndef SKIP_PH
        { PHASE_IDS();
        if (l + 1 < DEPTH) { ln_rows(U, a.in[23] + l * D, a.in[24] + l * D, Hf, Hb, gw, NGW, lane); conv_weights(a, l + 1, lds, gw, NGW, wave, lane); GRID_BAR(); }
        else ln_rows(U, a.in[23] + l * D, a.in[24] + l * D, a.out, (bf16*)nullptr, gw, NGW, lane);
        }
#endif
    }
}

extern "C" void kernel_launch(void* const* d_in, const int* in_sizes, int n_in, void* d_out, int out_size, void* d_ws, size_t ws_size, hipStream_t stream) {
    static int grid = 0;
    if (grid == 0) {
        if (n_in != 25 || out_size != M * D || ws_size < WS_END) { fprintf(stderr, "kernel_launch: unexpected shapes (n_in %d, out %d, ws %zu < %zu)\n", n_in, out_size, ws_size, (size_t)WS_END); grid = -1; return; }
        int dev = 0, cus = 0, per_cu = 0;
        hipGetDevice(&dev); hipDeviceGetAttribute(&cus, hipDeviceAttributeMultiprocessorCount, dev);
        if (hipFuncSetAttribute((const void*)mk_fwd, hipFuncAttributeMaxDynamicSharedMemorySize, LDS_BYTES) != hipSuccess) { fprintf(stderr, "kernel_launch: hipFuncSetAttribute failed\n"); grid = -1; return; }
        if (hipOccupancyMaxActiveBlocksPerMultiprocessor(&per_cu, (const void*)mk_fwd, NWAVES * 64, LDS_BYTES) != hipSuccess || per_cu < 1) { fprintf(stderr, "kernel_launch: occupancy query says %d\n", per_cu); per_cu = 1; }
        (void)hipGetLastError();
        grid = cus * 1;
    }
    if (grid < 0) return;
    Args a{};
    for (int i = 0; i < 25; ++i) a.in[i] = (const float*)d_in[i];
    a.out = (float*)d_out; a.ws = (unsigned char*)d_ws;
    if (hipMemsetAsync(d_ws, 0, 16384, stream) != hipSuccess) { fprintf(stderr, "kernel_launch: memset of the barrier words failed\n"); return; }
    void* args[] = {&a};
    hipError_t e = hipLaunchCooperativeKernel((const void*)mk_fwd, dim3(grid), dim3(NWAVES * 64), args, LDS_BYTES, stream);
    if (e != hipSuccess) fprintf(stderr, "kernel_launch: cooperative launch failed: %s (grid %d)\n", hipGetErrorString(e), grid);
}
```

```cpp
#include <hip/hip_runtime.h>
#include <hip/hip_cooperative_groups.h>
#include <cstdio>
#include <cstdint>
namespace cg = cooperative_groups;

namespace pg8 {
#define PG8_LAS __attribute__((address_space(3)))
typedef unsigned short bf16_t;
typedef short bf16x8 __attribute__((ext_vector_type(8)));
typedef float f32x4 __attribute__((ext_vector_type(4)));
typedef unsigned u32x4 __attribute__((ext_vector_type(4)));
constexpr int BM = 256, BK = 64, HALF = 128, HTB = HALF * BK * 2, STAGE_BYTES = 8 * HTB, NXCD = 8, WGM = 8;

__host__ __device__ __forceinline__ int lds_byte(int r, int c) { const int st = (r >> 4) * 2 + (c >> 5), rr = r & 15, cc = c & 31, ob = rr * 64 + cc * 2; return st * 1024 + (ob ^ (((ob >> 9) & 1) << 5)); }
__host__ __device__ __forceinline__ void stage_rc(int b, int& R, int& C) { const int st = b / 1024, sb = b % 1024, swz = sb ^ (((sb >> 9) & 1) << 5); R = (st >> 1) * 16 + swz / 64; C = (st & 1) * 32 + (swz % 64) / 2; }
__host__ __device__ __forceinline__ int perm32(int rho) { const int n = rho >> 4, i = rho & 15; return 8 * (i >> 2) + 4 * n + (i & 3); }

struct Unit { int pm, pn, koff; };
struct Gemm { const bf16_t* A; const bf16_t* Bt; int M, N, K, lda; };

struct StaticOrder {
    int nM, nN, nwg, G, c;
    __host__ __device__ void init(int M, int N, int G_, int c_) { nM = M / BM; nN = N / BM; nwg = nM * nN; G = G_; c = c_; }
    __host__ __device__ bool next(int i, Unit& u) const {
        const long L = (long)i * G + c; if (L >= nwg) return false;
        int wgid = (int)L; { const int q = nwg / NXCD, r = nwg % NXCD, xcd = wgid % NXCD, off = wgid / NXCD; wgid = (xcd < r ? xcd * (q + 1) : r * (q + 1) + (xcd - r) * q) + off; }
        const int nig = WGM * nN, gid = wgid / nig, fm = gid * WGM, gsz = (nM - fm) < WGM ? (nM - fm) : WGM;
        u.pm = fm + ((wgid % nig) % gsz); u.pn = (wgid % nig) / gsz; u.koff = 0; return true;
    }
    __device__ __forceinline__ void a_ready(const Unit&) const {}
    __device__ __forceinline__ void done(const Unit&) const {}
};
struct BranchOrder {
    int G, c;
    __host__ __device__ bool next(int i, Unit& u) const {
        const int j = i / 3, br = i - 3 * j; const long L = (long)j * G + c; if (L >= 256) return false;
        u.pm = (int)(L >> 2); u.pn = br * 4 + (int)(L & 3); u.koff = br * 512; return true;
    }
    __device__ __forceinline__ void a_ready(const Unit&) const {}
    __device__ __forceinline__ void done(const Unit&) const {}
};

__device__ __forceinline__ unsigned cvt_pk_bf16(float lo, float hi) { unsigned r; asm volatile("v_cvt_pk_bf16_f32 %0, %1, %2" : "=v"(r) : "v"(lo), "v"(hi)); return r; }
__device__ __forceinline__ float bf2f(unsigned short b) { return __uint_as_float((unsigned)b << 16); }
__device__ __forceinline__ float sigmoidf_(float x) { return __builtin_amdgcn_rcpf(1.0f + __expf(-x)); }
__device__ __forceinline__ u32x4 pack8(const f32x4 v0, const f32x4 v1) { u32x4 w; w.x = cvt_pk_bf16(v0[0], v0[1]); w.y = cvt_pk_bf16(v0[2], v0[3]); w.z = cvt_pk_bf16(v1[0], v1[1]); w.w = cvt_pk_bf16(v1[2], v1[3]); return w; }
__device__ __forceinline__ void unpack8(const u32x4 w, f32x4& v0, f32x4& v1) {
    v0[0] = __uint_as_float(w.x << 16); v0[1] = __uint_as_float(w.x & 0xffff0000u); v0[2] = __uint_as_float(w.y << 16); v0[3] = __uint_as_float(w.y & 0xffff0000u);
    v1[0] = __uint_as_float(w.z << 16); v1[1] = __uint_as_float(w.z & 0xffff0000u); v1[2] = __uint_as_float(w.w << 16); v1[3] = __uint_as_float(w.w & 0xffff0000u); }

constexpr int T_SEQ = 2048;
struct Epi1 {
    static constexpr bool PERM = true, AFTER_DRAIN = false;
    bf16_t *QK, *VT, *PRW, *HG, *GATE; const float* lbl; int layer;
    __device__ __forceinline__ void operator()(const f32x4 (&acc)[2][2][4][2], const Unit& u, int wr, int wc, int fr, int fq) const {
        const int pn = u.pn; const int row0 = u.pm * BM + wr * 64 + fr;
        if (pn == 4 || pn == 5) {
#pragma unroll
            for (int ai = 0; ai < 2; ++ai)
#pragma unroll
                for (int m = 0; m < 4; ++m) { const int row = row0 + ai * HALF + m * 16; const int b = row >> 11, t = row & (T_SEQ - 1);
#pragma unroll
                    for (int bj = 0; bj < 2; ++bj)
#pragma unroll
                        for (int n = 0; n < 2; ++n) { const int cv = (pn - 4) * 256 + bj * HALF + wc * 32 + 8 * fq + 4 * n; const int hh = cv >> 6, d = cv & 63;
                            bf16_t* p = VT + ((size_t)((b * 8 + hh) * 64 + d)) * T_SEQ + t; const f32x4 v = acc[ai][bj][m][n];
                            const unsigned w0 = cvt_pk_bf16(v[0], v[1]), w1 = cvt_pk_bf16(v[2], v[3]);
                            p[0] = (bf16_t)(w0 & 0xffffu); p[T_SEQ] = (bf16_t)(w0 >> 16); p[2 * T_SEQ] = (bf16_t)(w1 & 0xffffu); p[3 * T_SEQ] = (bf16_t)(w1 >> 16); } }
            return;
        }
        bf16_t* base; int ldc, colt; int mode = 0;
        if (pn < 4) { base = QK; ldc = 1024; colt = pn * 256; }
        else if (pn < 13) { base = PRW; ldc = 1792; colt = (pn - 6) * 256; }
        else if (pn < 21) { base = HG; ldc = 2048; colt = (pn - 13) * 256; mode = pn < 15 ? 0 : (pn < 17 ? 3 : 2); }
        else { base = GATE; ldc = 3072; colt = (pn - 21) * 256; mode = 1; }
        const int col0 = colt + wc * 32 + 8 * fq;
        f32x4 om[2][2];
        if (mode == 3) {
#pragma unroll
            for (int bj = 0; bj < 2; ++bj)
#pragma unroll
                for (int n = 0; n < 2; ++n)
#pragma unroll
                    for (int j = 0; j < 4; ++j) { const float* lg = lbl + (col0 - 512 + bj * HALF + 4 * n + j); const float l0 = lg[0], l1 = lg[512], l2 = lg[1024], l3 = lg[1536];
                        const float mx = fmaxf(fmaxf(l0, l1), fmaxf(l2, l3)); const float e0 = __expf(l0 - mx), e1 = __expf(l1 - mx), e2 = __expf(l2 - mx), e3 = __expf(l3 - mx);
                        const float num = (layer >= 1 ? e1 : 0.f) + (layer >= 2 ? e2 : 0.f) + (layer >= 3 ? e3 : 0.f); om[bj][n][j] = 1.f - num / (e0 + e1 + e2 + e3); }
        }
#pragma unroll
        for (int ai = 0; ai < 2; ++ai)
#pragma unroll
            for (int m = 0; m < 4; ++m) { bf16_t* rowp = base + (size_t)(row0 + ai * HALF + m * 16) * ldc + col0;
#pragma unroll
                for (int bj = 0; bj < 2; ++bj) { f32x4 v0 = acc[ai][bj][m][0], v1 = acc[ai][bj][m][1];
                    if (mode == 1) {
#pragma unroll
                        for (int j = 0; j < 4; ++j) { v0[j] = sigmoidf_(v0[j]); v1[j] = sigmoidf_(v1[j]); } }
                    else if (mode == 2) {
#pragma unroll
                        for (int j = 0; j < 4; ++j) { v0[j] = v0[j] * sigmoidf_(v0[j]); v1[j] = v1[j] * sigmoidf_(v1[j]); } }
                    else if (mode == 3) {
#pragma unroll
                        for (int j = 0; j < 4; ++j) { v0[j] = om[bj][0][j] * sigmoidf_(-v0[j]); v1[j] = om[bj][1][j] * sigmoidf_(-v1[j]); } }
                    *(u32x4*)(rowp + bj * HALF) = pack8(v0, v1); } }
    }
};
struct EpiLora {
    static constexpr bool PERM = true, AFTER_DRAIN = false;
    float* LWA; bf16_t* LG;
    __device__ __forceinline__ void operator()(const f32x4 (&acc)[2][2][4][2], const Unit& u, int wr, int wc, int fr, int fq) const {
        const int pn = u.pn; const int row0 = u.pm * BM + wr * 64 + fr;
        if (pn < 4) { float* base = LWA + (size_t)row0 * 1024 + pn * 256 + wc * 32 + 8 * fq;
#pragma unroll
            for (int ai = 0; ai < 2; ++ai)
#pragma unroll
                for (int m = 0; m < 4; ++m) { float* p = base + (size_t)(ai * HALF + m * 16) * 1024;
#pragma unroll
                    for (int bj = 0; bj < 2; ++bj) { *(f32x4*)(p + bj * HALF) = acc[ai][bj][m][0]; *(f32x4*)(p + bj * HALF + 4) = acc[ai][bj][m][1]; }
                    asm volatile("" ::: "memory"); }
        } else { bf16_t* base = LG + (size_t)row0 * 512 + (pn - 4) * 256 + wc * 32 + 8 * fq;
#pragma unroll
            for (int ai = 0; ai < 2; ++ai)
#pragma unroll
                for (int m = 0; m < 4; ++m) { bf16_t* p = base + (size_t)(ai * HALF + m * 16) * 512;
#pragma unroll
                    for (int bj = 0; bj < 2; ++bj) *(u32x4*)(p + bj * HALF) = pack8(acc[ai][bj][m][0], acc[ai][bj][m][1]);
                    asm volatile("" ::: "memory"); }
        }
    }
};
struct Epi2 {
    static constexpr bool PERM = true, AFTER_DRAIN = false;
    const bf16_t* GATE; float* MG; bf16_t* MERGED;
    __device__ __forceinline__ void operator()(const f32x4 (&acc)[2][2][4][2], const Unit& u, int wr, int wc, int fr, int fq) const {
        const int br = u.pn >> 2, pc = u.pn & 3; const int row0 = u.pm * BM + wr * 64 + fr; const int col0 = pc * 256 + wc * 32 + 8 * fq;
#pragma unroll
        for (int ai = 0; ai < 2; ++ai)
#pragma unroll
            for (int m = 0; m < 4; ++m) { const size_t row = (size_t)(row0 + ai * HALF + m * 16);
#pragma unroll
                for (int bj = 0; bj < 2; ++bj) { const int col = col0 + bj * HALF;
                    const u32x4 gw = *(const u32x4*)(GATE + row * 3072 + br * 1024 + col); f32x4 g0, g1; unpack8(gw, g0, g1);
                    f32x4 v0 = acc[ai][bj][m][0] * g0, v1 = acc[ai][bj][m][1] * g1; float* mp = MG + row * 1024 + col;
                    if (br > 0) { v0 += *(const f32x4*)mp; v1 += *(const f32x4*)(mp + 4); }
                    if (br < 2) { *(f32x4*)mp = v0; *(f32x4*)(mp + 4) = v1; }
                    else *(u32x4*)(MERGED + row * 1024 + col) = pack8(v0, v1); } }
    }
};
struct Epi3 {
    static constexpr bool PERM = true, AFTER_DRAIN = false;
    const float* H; float* U; float alpha;
    __device__ __forceinline__ void operator()(const f32x4 (&acc)[2][2][4][2], const Unit& u, int wr, int wc, int fr, int fq) const {
        const int row0 = u.pm * BM + wr * 64 + fr; const int col0 = u.pn * 256 + wc * 32 + 8 * fq;
#pragma unroll
        for (int ai = 0; ai < 2; ++ai)
#pragma unroll
            for (int m = 0; m < 4; ++m) { const size_t off = (size_t)(row0 + ai * HALF + m * 16) * 1024 + col0;
#pragma unroll
                for (int bj = 0; bj < 2; ++bj) { const float* hp = H + off + bj * HALF; float* up = U + off + bj * HALF;
                    const f32x4 h0 = *(const f32x4*)hp, h1 = *(const f32x4*)(hp + 4);
                    *(f32x4*)up = h0 * alpha + acc[ai][bj][m][0]; *(f32x4*)(up + 4) = h1 * alpha + acc[ai][bj][m][1]; } }
    }
};
struct Epi4 {
    static constexpr bool PERM = true, AFTER_DRAIN = false;
    bf16_t* ACT;
    __device__ __forceinline__ void operator()(const f32x4 (&acc)[2][2][4][2], const Unit& u, int wr, int wc, int fr, int fq) const {
        const int row0 = u.pm * BM + wr * 64 + fr; const int col0 = u.pn * 128 + wc * 32 + 8 * fq;
#pragma unroll
        for (int ai = 0; ai < 2; ++ai)
#pragma unroll
            for (int m = 0; m < 4; ++m) { f32x4 v0, v1;
#pragma unroll
                for (int j = 0; j < 4; ++j) { const float a0 = acc[ai][0][m][0][j], a1 = acc[ai][0][m][1][j];
                    v0[j] = a0 * sigmoidf_(a0) * acc[ai][1][m][0][j]; v1[j] = a1 * sigmoidf_(a1) * acc[ai][1][m][1][j]; }
                *(u32x4*)(ACT + (size_t)(row0 + ai * HALF + m * 16) * 2816 + col0) = pack8(v0, v1); }
    }
};
template <class Epi, class Sched, bool ALIGN_EPI = false, bool SP2 = false>
__device__ __forceinline__ void gemm_phase(PG8_LAS unsigned char* lds, const Gemm g, const Sched& S, const Epi& E) {
    int tid_o = threadIdx.x; asm volatile("" : "+v"(tid_o));
    const int tid = tid_o, wid = __builtin_amdgcn_readfirstlane(tid >> 6), lane = tid & 63, wr = wid >> 2, wc = wid & 3, fr = lane & 15, fq = lane >> 4;
    const int K = g.K, nt = K / BK;
    unsigned voffA[2], voffB[2];
#pragma unroll
    for (int i = 0; i < 2; ++i) { int R, C; stage_rc(tid * 16 + i * 8192, R, C); const int Rb = Epi::PERM ? ((R & ~31) + perm32(R & 31)) : R;
        voffA[i] = (unsigned)(R * g.lda + C) * 2u; voffB[i] = (unsigned)(Rb * K + C) * 2u; }
    const size_t kstep = (size_t)(BK * 2);
    const size_t hstep = (size_t)HALF * K * 2;
    const size_t tstep = 2 * hstep; const size_t hstepA = (size_t)HALF * g.lda * 2, tstepA = 2 * hstepA;
    const unsigned ldsw = (unsigned)wid * 1024u;
    const int aoff = lds_byte(wr * 64 + fr, fq * 8), boff = lds_byte(wc * 32 + fr, fq * 8);
#define PG8_SA(b, h) (((b) * 2 + (h)) * HTB)
#define PG8_SB(b, h) ((4 + (b) * 2 + (h)) * HTB)
#define PG8_STAGE(bufoff, gbase, voff) do { _Pragma("unroll") for (int _i = 0; _i < 2; ++_i) \
        __builtin_amdgcn_global_load_lds((const unsigned*)((const char*)(gbase) + (voff)[_i]), (PG8_LAS unsigned*)(lds + (bufoff) + ldsw + _i * 8192), 16, 0, 0); } while (0)
#define PG8_LDA(dst, b, h) do { _Pragma("unroll") for (int m = 0; m < 4; ++m) _Pragma("unroll") for (int k = 0; k < 2; ++k) dst[m][k] = *(const PG8_LAS bf16x8*)(lds + PG8_SA(b, h) + aoff + m * 2048 + k * 1024); } while (0)
#define PG8_LDB(dst, b, h) do { _Pragma("unroll") for (int n = 0; n < 2; ++n) _Pragma("unroll") for (int k = 0; k < 2; ++k) dst[n][k] = *(const PG8_LAS bf16x8*)(lds + PG8_SB(b, h) + boff + n * 2048 + k * 1024); } while (0)
#define PG8_MMA(ai, bj, At, Bt) do { __builtin_amdgcn_s_setprio(1); _Pragma("unroll") for (int m = 0; m < 4; ++m) _Pragma("unroll") for (int n = 0; n < 2; ++n) _Pragma("unroll") for (int k = 0; k < 2; ++k) \
        acc[ai][bj][m][n] = __builtin_amdgcn_mfma_f32_16x16x32_bf16(Bt[n][k], At[m][k], acc[ai][bj][m][n], 0, 0, 0); __builtin_amdgcn_s_setprio(0); } while (0)
#define PG8_WAIT_V(n) asm volatile("s_waitcnt vmcnt(" #n ")" ::: "memory")
#define PG8_WAIT_L(n) asm volatile("s_waitcnt lgkmcnt(" #n ")" ::: "memory")
#define PG8_BAR __builtin_amdgcn_s_barrier()
#define PG8_SCHED __builtin_amdgcn_sched_barrier(0)
    Unit cur, nxt; int ui = 0;
    if (!S.next(0, cur)) return;
    f32x4 acc[2][2][4][2];
#pragma unroll
    for (int a = 0; a < 2; ++a)
#pragma unroll
        for (int b = 0; b < 2; ++b)
#pragma unroll
            for (int m = 0; m < 4; ++m)
#pragma unroll
                for (int n = 0; n < 2; ++n) acc[a][b][m][n] = (f32x4){0.f, 0.f, 0.f, 0.f};
    bf16x8 At[4][2], B0[2][2], B1[2][2];
    const char* cA = (const char*)g.A + (size_t)cur.pm * tstepA + (size_t)cur.koff * 2; const char* cB = (const char*)g.Bt + (size_t)cur.pn * tstep;
    S.a_ready(cur);
    if constexpr (SP2) {
        PG8_STAGE(PG8_SB(0, 0), cB, voffB); PG8_STAGE(PG8_SB(0, 1), cB + hstep, voffB); PG8_STAGE(PG8_SA(0, 0), cA, voffA); PG8_STAGE(PG8_SA(0, 1), cA + hstepA, voffA);
        if (wr == 1) PG8_BAR;
        PG8_WAIT_V(2); PG8_BAR;
        PG8_STAGE(PG8_SB(1, 0), cB + kstep, voffB); PG8_STAGE(PG8_SA(1, 0), cA + kstep, voffA); PG8_STAGE(PG8_SB(1, 1), cB + hstep + kstep, voffB);
        PG8_WAIT_V(6); PG8_BAR;
    } else {
        PG8_STAGE(PG8_SB(0, 0), cB, voffB); PG8_STAGE(PG8_SA(0, 0), cA, voffA); PG8_STAGE(PG8_SB(0, 1), cB + hstep, voffB); PG8_STAGE(PG8_SA(0, 1), cA + hstepA, voffA);
        if (wr == 1) PG8_BAR;
        PG8_WAIT_V(4); PG8_BAR;
        PG8_STAGE(PG8_SB(1, 0), cB + kstep, voffB); PG8_STAGE(PG8_SA(1, 0), cA + kstep, voffA); PG8_STAGE(PG8_SB(1, 1), cB + hstep + kstep, voffB);
        PG8_WAIT_V(6); PG8_BAR;
    }
    for (;;) {
        const bool has_next = S.next(ui + 1, nxt);
        const char* nA = has_next ? (const char*)g.A + (size_t)nxt.pm * tstepA + (size_t)nxt.koff * 2 : cA; const char* nB = has_next ? (const char*)g.Bt + (size_t)nxt.pn * tstep : cB;
        for (int t = 0; t < nt; t += 2) {
            const bool last = (t == nt - 2);
            const char* a1 = cA + (size_t)(t + 1) * kstep;
            const char* a2 = last ? nA : cA + (size_t)(t + 2) * kstep; const char* b2 = last ? nB : cB + (size_t)(t + 2) * kstep;
            const char* a3 = a2 + kstep; const char* b3 = b2 + kstep;
            if (last && has_next) S.a_ready(nxt);
            if constexpr (SP2) {
            PG8_LDB(B0, 0, 0); PG8_LDB(B1, 0, 1); PG8_SCHED; PG8_LDA(At, 0, 0); PG8_STAGE(PG8_SA(1, 1), a1 + hstepA, voffA);
            PG8_WAIT_V(8); PG8_WAIT_L(0); PG8_BAR; PG8_MMA(0, 0, At, B0); PG8_MMA(0, 1, At, B1); PG8_BAR; PG8_SCHED;
            PG8_LDA(At, 0, 1); PG8_STAGE(PG8_SB(0, 0), b2, voffB); PG8_STAGE(PG8_SB(0, 1), b2 + hstep, voffB); PG8_STAGE(PG8_SA(0, 0), a2, voffA);
            PG8_WAIT_V(8); PG8_WAIT_L(0); PG8_BAR; PG8_MMA(1, 0, At, B0); PG8_MMA(1, 1, At, B1); PG8_BAR; PG8_SCHED;
            PG8_LDB(B0, 1, 0); PG8_LDB(B1, 1, 1); PG8_SCHED; PG8_LDA(At, 1, 0); PG8_STAGE(PG8_SA(0, 1), a2 + hstepA, voffA);
            PG8_WAIT_V(8); PG8_WAIT_L(0); PG8_BAR; PG8_MMA(0, 0, At, B0); PG8_MMA(0, 1, At, B1); PG8_BAR; PG8_SCHED;
            PG8_LDA(At, 1, 1); PG8_STAGE(PG8_SB(1, 0), b3, voffB); PG8_STAGE(PG8_SB(1, 1), b3 + hstep, voffB); PG8_STAGE(PG8_SA(1, 0), a3, voffA);
            PG8_WAIT_V(8); PG8_WAIT_L(0); PG8_BAR; PG8_MMA(1, 0, At, B0); PG8_MMA(1, 1, At, B1); PG8_BAR; PG8_SCHED;
            } else {
            PG8_LDB(B0, 0, 0); PG8_SCHED; PG8_LDA(At, 0, 0); PG8_STAGE(PG8_SA(1, 1), a1 + hstepA, voffA);
            PG8_WAIT_L(8); PG8_BAR; PG8_WAIT_L(0); PG8_MMA(0, 0, At, B0); PG8_BAR; PG8_SCHED;
            PG8_LDB(B1, 0, 1); PG8_STAGE(PG8_SB(0, 0), b2, voffB);
            PG8_BAR; PG8_WAIT_L(0); PG8_MMA(0, 1, At, B1); PG8_BAR;
            PG8_LDA(At, 0, 1); PG8_STAGE(PG8_SA(0, 0), a2, voffA);
            PG8_BAR; PG8_WAIT_L(0); PG8_MMA(1, 0, At, B0); PG8_BAR; PG8_SCHED;
            PG8_STAGE(PG8_SB(0, 1), b2 + hstep, voffB);
            PG8_WAIT_V(6); PG8_BAR; PG8_MMA(1, 1, At, B1); PG8_BAR;
            PG8_LDB(B0, 1, 0); PG8_SCHED; PG8_LDA(At, 1, 0); PG8_STAGE(PG8_SA(0, 1), a2 + hstepA, voffA);
            PG8_WAIT_L(8); PG8_BAR; PG8_WAIT_L(0); PG8_MMA(0, 0, At, B0); PG8_BAR; PG8_SCHED;
            PG8_LDB(B1, 1, 1); PG8_STAGE(PG8_SB(1, 0), b3, voffB);
            PG8_BAR; PG8_WAIT_L(0); PG8_MMA(0, 1, At, B1); PG8_BAR;
            PG8_LDA(At, 1, 1); PG8_STAGE(PG8_SA(1, 0), a3, voffA);
            PG8_BAR; PG8_WAIT_L(0); PG8_MMA(1, 0, At, B0); PG8_BAR; PG8_SCHED;
            PG8_STAGE(PG8_SB(1, 1), b3 + hstep, voffB);
            PG8_WAIT_V(6); PG8_BAR; PG8_MMA(1, 1, At, B1); PG8_BAR;
            }
        }
        if constexpr (ALIGN_EPI) { if (wr == 0) PG8_BAR; }
        if constexpr (!Epi::AFTER_DRAIN) { E(acc, cur, wr, wc, fr, fq); S.done(cur); }
        if (!has_next) break;
#pragma unroll
        for (int a = 0; a < 2; ++a)
#pragma unroll
            for (int b = 0; b < 2; ++b)
#pragma unroll
                for (int m = 0; m < 4; ++m)
#pragma unroll
                    for (int n = 0; n < 2; ++n) acc[a][b][m][n] = (f32x4){0.f, 0.f, 0.f, 0.f};
        cur = nxt; cA = nA; cB = nB; ++ui;
        if constexpr (ALIGN_EPI) { if (wr == 1) PG8_BAR; }
    }
    PG8_WAIT_V(0);
    if constexpr (!ALIGN_EPI) { if (wr == 0) PG8_BAR; }
    PG8_BAR;
    if constexpr (Epi::AFTER_DRAIN) { E.fused(acc, cur, wr, wc, fr, fq, lds, wid, lane); S.done(cur); }
#undef PG8_SA
#undef PG8_SB
#undef PG8_STAGE
#undef PG8_LDA
#undef PG8_LDB
#undef PG8_MMA
#undef PG8_WAIT_V
#undef PG8_WAIT_L
#undef PG8_BAR
#undef PG8_SCHED
}
}

typedef unsigned short bf16;
typedef short bf16x8 __attribute__((ext_vector_type(8)));
typedef float f32x4 __attribute__((ext_vector_type(4)));
typedef float f32x16 __attribute__((ext_vector_type(16)));
typedef unsigned v4u __attribute__((ext_vector_type(4)));
#define LAS __attribute__((address_space(3)))
constexpr int NB = 8, TS = 2048, M = NB * TS, D = 1024, DEPTH = 4, MIXW = 512, RWIN = 1792, INC = 8448, DFF = 2816;
constexpr float ALPHA = 1.681792830507429f;
constexpr float LN_EPS = 1e-5f, GN_EPS = 64e-5f, RMS_EPS = 1e-6f;
constexpr size_t MiB = 1u << 20;
constexpr size_t WS_WIN = 1 * MiB, WS_WUP = 18 * MiB, WS_WOUT = 21 * MiB, WS_WFI = 23 * MiB, WS_WFO = 34 * MiB, WS_WLORA = 40 * MiB, WS_BON = 41 * MiB;
constexpr size_t WS_H = 42 * MiB, WS_HB = 106 * MiB, WS_QK = 138 * MiB, WS_VT = 170 * MiB, WS_HG = 186 * MiB, WS_PRW = 250 * MiB, WS_GATE = 306 * MiB;
constexpr size_t WS_Y = 402 * MiB, WS_T = 450 * MiB, WS_LWA = 458 * MiB, WS_END = 522 * MiB;
constexpr size_t WS_LG = 138 * MiB, WS_YRAW = 154 * MiB, WS_MG = 138 * MiB, WS_MERGED = 202 * MiB, WS_U = 250 * MiB, WS_ACT = 314 * MiB;
constexpr int LDS_BYTES = 147456;
constexpr int NWAVES = 8;

struct Args { const float* in[25]; float* out; unsigned char* ws; };

__device__ __forceinline__ float bf2f(bf16 b) { return __uint_as_float((unsigned)b << 16); }
__device__ __forceinline__ bf16 f2bf(float f) { return (bf16)(pg8::cvt_pk_bf16(f, 0.f) & 0xffffu); }
__device__ __forceinline__ float sigm(float x) { return __builtin_amdgcn_rcpf(1.0f + __expf(-x)); }
__device__ __forceinline__ float wave_sum(float v) {
#pragma unroll
    for (int o = 1; o < 64; o <<= 1) v += __shfl_xor(v, o);
    return v;
}
template <int CTRL> __device__ __forceinline__ float dppf(float x) { return __builtin_bit_cast(float, __builtin_amdgcn_update_dpp(0, __builtin_bit_cast(int, x), CTRL, 0xF, 0xF, true)); }
__device__ __forceinline__ float row16_sum(float x) {
    x += dppf<0xB1>(x); x += dppf<0x4E>(x); x += dppf<0x141>(x); x += dppf<0x140>(x); return x;
}
#define LDS_WAIT() asm volatile("s_waitcnt lgkmcnt(0)" ::: "memory")

__device__ __forceinline__ void transpose_item(const float* W, int K, int N, bf16* WT, int k0, int n0, int drow0, LAS float* scr, int lane) {
#pragma unroll
    for (int i = 0; i < 32; ++i) { const int kk = 2 * i + (lane >> 5); scr[kk * 33 + (lane & 31)] = W[(size_t)(k0 + kk) * N + n0 + (lane & 31)]; }
    LDS_WAIT(); asm volatile("" ::: "memory");
    const int c = lane & 7;
#pragma unroll
    for (int j = 0; j < 4; ++j) { const int n = (lane >> 3) + 8 * j; const LAS float* s = scr + (8 * c) * 33 + n;
        v4u o; o.x = pg8::cvt_pk_bf16(s[0 * 33], s[1 * 33]); o.y = pg8::cvt_pk_bf16(s[2 * 33], s[3 * 33]); o.z = pg8::cvt_pk_bf16(s[4 * 33], s[5 * 33]); o.w = pg8::cvt_pk_bf16(s[6 * 33], s[7 * 33]);
        *(v4u*)(WT + (size_t)(drow0 + n) * K + k0 + 8 * c) = o; }
    LDS_WAIT(); asm volatile("" ::: "memory");
}
__device__ __forceinline__ void conv_weights(const Args& a, int l, LAS unsigned char* lds, int gw, int NGW, int wave, int lane) {
    unsigned char* ws = a.ws;
    LAS float* scr = (LAS float*)(lds + wave * 16384);
    const float* Win = a.in[3] + (size_t)l * D * INC; const float* Wup = a.in[17] + (size_t)l * 3 * MIXW * D; const float* Wout = a.in[18] + (size_t)l * D * D;
    const float* Wfi = a.in[21] + (size_t)l * D * 2 * DFF; const float* Wfo = a.in[22] + (size_t)l * DFF * D;
    constexpr int I_IN = (D / 64) * (INC / 32), I_UP = (MIXW / 64) * (D / 32), I_OUT = (D / 64) * (D / 32), I_FI = (D / 64) * (2 * DFF / 32), I_FO = (DFF / 64) * (D / 32);
    constexpr int NITEMS = I_IN + 3 * I_UP + I_OUT + I_FI + I_FO;
    for (int it = gw; it < NITEMS; it += NGW) {
        int r = it;
        if (r < I_IN) { const int nblk = INC / 32, kb = r / nblk, nb = r % nblk; transpose_item(Win, D, INC, (bf16*)(ws + WS_WIN), 64 * kb, 32 * nb, 32 * nb, scr, lane); continue; } r -= I_IN;
        if (r < 3 * I_UP) { const int br = r / I_UP; r -= br * I_UP; const int nblk = D / 32, kb = r / nblk, nb = r % nblk;
            transpose_item(Wup + (size_t)br * MIXW * D, MIXW, D, (bf16*)(ws + WS_WUP), 64 * kb, 32 * nb, br * D + 32 * nb, scr, lane); continue; } r -= 3 * I_UP;
        if (r < I_OUT) { const int nblk = D / 32, kb = r / nblk, nb = r % nblk; transpose_item(Wout, D, D, (bf16*)(ws + WS_WOUT), 64 * kb, 32 * nb, 32 * nb, scr, lane); continue; } r -= I_OUT;
        if (r < I_FI) { const int nblk = 2 * DFF / 32, kb = r / nblk, nb = r % nblk; const int n0 = 32 * nb; const int half = n0 >= DFF ? 1 : 0, nn = n0 - half * DFF;
            transpose_item(Wfi, D, 2 * DFF, (bf16*)(ws + WS_WFI), 64 * kb, n0, 256 * (nn >> 7) + 128 * half + (nn & 127), scr, lane); continue; } r -= I_FI;
        { const int nblk = D / 32, kb = r / nblk, nb = r % nblk; transpose_item(Wfo, DFF, D, (bf16*)(ws + WS_WFO), 64 * kb, 32 * nb, 32 * nb, scr, lane); }
    }
    const float* wu = a.in[6] + (size_t)l * 64 * MIXW; const float* au = a.in[8] + (size_t)l * 64 * MIXW; const float* gu = a.in[9] + (size_t)l * 128 * MIXW;
    bf16* WL = (bf16*)(ws + WS_WLORA);
    for (int idx = gw * 64 + lane; idx < 1536 * 256; idx += NGW * 64) { const int n = idx >> 8, k = idx & 255; float v = 0.f;
        if (n < 512) { if (k < 64) v = wu[k * MIXW + n]; } else if (n < 1024) { if (k >= 64 && k < 128) v = au[(k - 64) * MIXW + n - 512]; } else { if (k >= 128) v = gu[(k - 128) * MIXW + n - 1024]; }
        WL[idx] = f2bf(v); }
}
__device__ __forceinline__ void ln_rows(const float* src, const float* gam, const float* bet, float* dstf, bf16* dstb, int gw, int NGW, int lane) {
    for (int m = gw; m < M; m += NGW) {
        const f32x4* xr = (const f32x4*)(src + (size_t)m * D) + lane;
        f32x4 v[4]; float s = 0.f;
#pragma unroll
        for (int j = 0; j < 4; ++j) { v[j] = xr[64 * j]; s += (v[j].x + v[j].y) + (v[j].z + v[j].w); }
        const float mean = wave_sum(s) * (1.f / D); float s2 = 0.f;
#pragma unroll
        for (int j = 0; j < 4; ++j) { v[j] = v[j] - mean; s2 += (v[j].x * v[j].x + v[j].y * v[j].y) + (v[j].z * v[j].z + v[j].w * v[j].w); }
        const float rstd = 1.f / sqrtf(wave_sum(s2) * (1.f / D) + LN_EPS);
        f32x4* of = (f32x4*)(dstf + (size_t)m * D) + lane; unsigned long long* ob = (unsigned long long*)(dstb + (size_t)m * D) + lane;
#pragma unroll
        for (int j = 0; j < 4; ++j) { const f32x4 g = ((const f32x4*)gam)[lane + 64 * j], b = ((const f32x4*)bet)[lane + 64 * j]; const f32x4 o = v[j] * rstd * g + b;
            of[64 * j] = o; if (dstb) ob[64 * j] = (unsigned long long)pg8::cvt_pk_bf16(o.x, o.y) | ((unsigned long long)pg8::cvt_pk_bf16(o.z, o.w) << 32); }
    }
}
#define XB_TMO      128
#define XB_XCNT(j)  (256  + 64 * (j))
#define XB_XSUB(j)  (1280 + 64 * (j))
#define XB_XGEN(j)  (2304 + 64 * (j))
#define XB_TOP      3328
#define XB_TOPGEN   3392
#define XCD_BAR_WORDS 3456
#define XB_SPIN_CAP (1u << 18)

__device__ __forceinline__ unsigned xb_ld(unsigned* p)              { return __hip_atomic_load(p, __ATOMIC_RELAXED, __HIP_MEMORY_SCOPE_AGENT); }
__device__ __forceinline__ unsigned xb_add(unsigned* p, unsigned v) { return __hip_atomic_fetch_add(p, v, __ATOMIC_RELAXED, __HIP_MEMORY_SCOPE_AGENT); }
__device__ __forceinline__ unsigned xb_xcc_id() { return (unsigned)__builtin_amdgcn_s_getreg((3 << 11) | 20) & 0xFu; }
#define XB_SPIN(cond, bar) do { unsigned _sp = 0; while (cond) { __builtin_amdgcn_s_sleep(1); \
    if ((++_sp & 255u) == 0u) { if (xb_ld(&(bar)[XB_TMO])) break; if (_sp > XB_SPIN_CAP) { atomicAdd(&(bar)[XB_TMO], 1u); break; } } } } while (0)

struct XcdBarrier {
    unsigned* bar; unsigned x;
    volatile LAS unsigned* st;
};

__device__ __forceinline__ XcdBarrier xcd_barrier_post(unsigned* bar, volatile LAS unsigned* st) {
    XcdBarrier b; b.bar = bar; b.x = xb_xcc_id(); b.st = st;
    if (threadIdx.x == 0) (void)xb_add(&bar[XB_XCNT(b.x)], 1u);
    return b;
}
__device__ __forceinline__ void xcd_barrier_complete(unsigned* bar, unsigned x, unsigned& nloc, unsigned& nx) {
    const unsigned G = gridDim.x * gridDim.y * gridDim.z;
    unsigned sum, cnt, mine, sp = 0u;
    for (;;) {
        sum = 0u; cnt = 0u; mine = 0u;
#pragma unroll
        for (unsigned j = 0; j < 16; ++j) { const unsigned c = xb_ld(&bar[XB_XCNT(j)]); sum += c; cnt += (c > 0u) ? 1u : 0u; mine = (j == x) ? c : mine; }
        if (sum == G) break;
        __builtin_amdgcn_s_sleep(1);
        if ((++sp & 255u) == 0u) { if (xb_ld(&bar[XB_TMO])) break; if (sp > XB_SPIN_CAP) { atomicAdd(&bar[XB_TMO], 1u); break; } }
    }
    nloc = mine > 0u ? mine : 1u; nx = cnt > 0u ? cnt : 1u;
}

__device__ __forceinline__ void xcd_barrier(const XcdBarrier& b) {
    asm volatile("s_waitcnt vmcnt(0)" ::: "memory");
    __syncthreads();
    if (threadIdx.x == 0) {
        unsigned* bar = b.bar;
        __builtin_amdgcn_s_waitcnt(0);
        unsigned nloc = b.st[0], nx = b.st[1];
        if (nloc == 0u) { xcd_barrier_complete(bar, b.x, nloc, nx); b.st[0] = nloc; b.st[1] = nx; }
        const unsigned old = xb_add(&bar[XB_XSUB(b.x)], 1u);
        const unsigned gen = old / nloc;
        if (old + 1u == (gen + 1u) * nloc) {
            __builtin_amdgcn_fence(__ATOMIC_RELEASE, "agent");
            asm volatile("s_waitcnt vmcnt(0)" ::: "memory");
            const unsigned og = xb_add(&bar[XB_TOP], 1u);
            const unsigned tg = og / nx;
            if (og + 1u == (tg + 1u) * nx) xb_add(&bar[XB_TOPGEN], 1u);
            else XB_SPIN(xb_ld(&bar[XB_TOPGEN]) == tg, bar);
            __builtin_amdgcn_fence(__ATOMIC_ACQUIRE, "agent");
            xb_add(&bar[XB_XGEN(b.x)], 1u);
            asm volatile("s_waitcnt vmcnt(0)" ::: "memory");
        } else {
            XB_SPIN(xb_ld(&bar[XB_XGEN(b.x)]) == gen, bar);
            __builtin_amdgcn_fence(__ATOMIC_ACQUIRE, "agent");
            asm volatile("s_waitcnt vmcnt(0)" ::: "memory");
        }
    }
    __syncthreads();
}
__device__ __forceinline__ void prep_lora_in(const Args& a, int l, int gtid, int NT) {
    const bf16* PRW = (const bf16*)(a.ws + WS_PRW); bf16* T = (bf16*)(a.ws + WS_T); const float* mu = a.in[4] + (size_t)l * RWIN + 1536;
    for (int idx = gtid; idx < M * 256; idx += NT) { const int t = idx >> 8, c = idx & 255; const bf16* p = PRW + (size_t)t * RWIN + 1536 + c;
        const float x = bf2f(p[0]); const float xp = (t & (TS - 1)) ? bf2f(p[-RWIN]) : 0.f; const float v = x + (xp - x) * mu[c];
        float o; if (c < 64) o = 1.f - 2.f * __builtin_amdgcn_rcpf(1.f + __expf(2.f * v)); else if (c < 128) o = v; else o = sigm(v);
        T[idx] = f2bf(o); }
}
__device__ __forceinline__ void rwkv_prep2(const Args& a, int l, int gw, int NGW, int lane) {
    const bf16* PRW = (const bf16*)(a.ws + WS_PRW); float* LWA = (float*)(a.ws + WS_LWA); float* BON = (float*)(a.ws + WS_BON);
    const float* mu = a.in[4] + (size_t)l * RWIN;
    float mu_r[8], mu_k[8], w0[8], a0[8], kkc[8], kac[8], rkc[8];
#pragma unroll
    for (int hh = 0; hh < 8; ++hh) { const int c = hh * 64 + lane; mu_r[hh] = mu[c]; mu_k[hh] = mu[512 + c]; w0[hh] = a.in[5][l * MIXW + c]; a0[hh] = a.in[7][l * MIXW + c];
        kkc[hh] = a.in[10][l * MIXW + c]; kac[hh] = a.in[11][l * MIXW + c]; rkc[hh] = a.in[12][l * MIXW + c]; }
    for (int t = gw; t < M; t += NGW) {
        const bool first = (t & (TS - 1)) == 0; const bf16* row = PRW + (size_t)t * RWIN + lane; float* lrow = LWA + (size_t)t * 1024 + lane;
        bf16 xr[8], xrp[8], xk[8], xkp[8]; float xlw[8], xla[8];
#pragma unroll
        for (int hh = 0; hh < 8; ++hh) { xr[hh] = row[hh * 64]; xrp[hh] = row[hh * 64 - RWIN]; xk[hh] = row[512 + hh * 64]; xkp[hh] = row[512 + hh * 64 - RWIN]; xlw[hh] = lrow[hh * 64]; xla[hh] = lrow[512 + hh * 64]; }
#pragma unroll
        for (int hh = 0; hh < 8; ++hh) {
            float r = bf2f(xr[hh]), k = bf2f(xk[hh]); const float rp = first ? 0.f : bf2f(xrp[hh]), kp_ = first ? 0.f : bf2f(xkp[hh]);
            r += (rp - r) * mu_r[hh]; k += (kp_ - k) * mu_k[hh];
            const float x = w0[hh] + xlw[hh]; const float sp = fmaxf(-x, 0.f) + __logf(1.f + __expf(-fabsf(x))); const float ld = -__expf(-sp - 0.5f);
            const float av = sigm(a0[hh] + xla[hh]);
            float kk = k * kkc[hh]; const float ss = wave_sum(kk * kk); kk *= rsqrtf(fmaxf(ss, 1e-24f));
            const float kp = k * (1.f + (av - 1.f) * kac[hh]);
            const float bon = wave_sum(r * kp * rkc[hh]); if (lane == 0) BON[(size_t)t * 8 + hh] = bon;
            ((unsigned*)lrow)[hh * 64] = pg8::cvt_pk_bf16(kk, kk * av); ((unsigned*)lrow)[512 + hh * 64] = pg8::cvt_pk_bf16(kp, ld);
        }
    }
}
__device__ __forceinline__ float grp_sum(float part) {
    part += dppf<0x128>(part);
    const f32x4 z = {0.f, 0.f, 0.f, 0.f};
    const f32x4 r = __builtin_amdgcn_mfma_f32_16x16x4f32(1.0f, part, z, 0, 0, 0);
    return r[0];
}
__device__ __forceinline__ void scan_phase(const Args& a, int l, int u, LAS unsigned char* lds, int tid) {
    constexpr int CH = 16, NCH = TS / CH;
    const int wv = tid >> 6, lane = tid & 63;
    const int role = wv >> 1;
    const int pt = tid & 127;
    const int rowi = 8 * (wv & 1) + (lane & 7), ks = lane >> 3;
    const int rb = u >> 5, rh = (u >> 2) & 7, qt = u & 3;
    const bf16* PRW = (const bf16*)(a.ws + WS_PRW); const unsigned* LWAu = (const unsigned*)(a.ws + WS_LWA); float* YRAW = (float*)(a.ws + WS_YRAW);
    LAS float* rwbuf = (LAS float*)lds; LAS float* rwob = (LAS float*)(lds + 43008);
    const int rch = pt & 63, rcc = rh * 64 + rch;
    const int hb = u >> 5, hh = (u >> 3) & 3, vq = u & 7;
    const bf16* HG = (const bf16*)(a.ws + WS_HG); bf16* Y = (bf16*)(a.ws + WS_Y);
    LAS float* hgbuf = (LAS float*)(lds + 45056); LAS float* hgob = (LAS float*)(lds + 96256);
    float mu_r = 0.f, mu_v = 0.f;
    if (role == 2) { const float* mu = a.in[4] + (size_t)l * RWIN; mu_r = mu[rcc]; mu_v = mu[1024 + rcc]; }
    f32x4 S0 = {0.f, 0.f, 0.f, 0.f}, S1 = S0, S2 = S0, S3 = S0;
    bf16 xr[8], xrp[8], xv[8], xvp[8]; unsigned xp0[8], xp1[8];
    bf16 rq[16], rf[16], ri[2];
    const bf16* pr_ = PRW + ((size_t)rb * TS + (pt >> 6)) * RWIN + rcc; const unsigned* pl_ = LWAu + ((size_t)rb * TS + (pt >> 6)) * 1024 + rcc;
    const bf16* pq = HG + ((size_t)hb * TS) * 2048 + hh * 128 + pt;
    const bf16* pi = HG + ((size_t)hb * TS + (pt >> 4)) * 2048 + 1024 + hh * 128 + vq * 16 + (pt & 15);
#define RW_LOAD(cn) do { _Pragma("unroll") for (int j = 0; j < 8; ++j) { const size_t ro = (size_t)((cn) * CH + 2 * j); const bf16* row = pr_ + ro * RWIN; \
        xr[j] = row[0]; xv[j] = row[1024]; xrp[j] = row[-RWIN]; xvp[j] = row[1024 - RWIN]; xp0[j] = pl_[ro * 1024]; xp1[j] = pl_[ro * 1024 + 512]; } } while (0)
#define HG_LOAD(cn) do { const size_t ro = (size_t)(cn) * CH * 2048; _Pragma("unroll") for (int j = 0; j < 16; ++j) { rq[j] = pq[ro + (size_t)j * 2048]; rf[j] = pq[ro + (size_t)j * 2048 + 512]; } \
        ri[0] = pi[ro]; ri[1] = pi[ro + (size_t)8 * 2048]; } while (0)
    if (role == 2) RW_LOAD(0);
    if (role == 3) HG_LOAD(0);
    __syncthreads();
#pragma unroll 1
    for (int c = -1; c < NCH; ++c) {
        if (role == 2) {
            if (c + 1 < NCH) { LAS float* bp = rwbuf + ((c + 1) & 1) * (CH * 336);
#pragma unroll
                for (int j = 0; j < 8; ++j) { const int tt = (pt >> 6) + 2 * j; const bool first = ((c + 1) * CH + tt) == 0;
                    float r = bf2f(xr[j]), v = bf2f(xv[j]); const float rp = first ? 0.f : bf2f(xrp[j]), vp = first ? 0.f : bf2f(xvp[j]);
                    r += (rp - r) * mu_r; v += (vp - v) * mu_v;
                    LAS float* rec = bp + tt * 336; rec[rch] = __uint_as_float(xp0[j] << 16); rec[64 + rch] = __expf(__uint_as_float(xp1[j] & 0xffff0000u));
                    rec[128 + rch] = __uint_as_float(xp0[j] & 0xffff0000u); rec[192 + rch] = __uint_as_float(xp1[j] << 16); rec[256 + rch] = r;
                    if ((rch >> 4) == qt) rec[320 + (rch & 15)] = v; }
                if (c + 2 < NCH) RW_LOAD(c + 2); }
            if (c >= 1) {
#pragma unroll
                for (int j = 0; j < 2; ++j) { const int idx = pt + 128 * j; YRAW[((size_t)rb * TS + (size_t)(c - 1) * CH + (idx >> 4)) * MIXW + rh * 64 + qt * 16 + (idx & 15)] = rwob[((c - 1) & 1) * 256 + idx]; } }
        } else if (role == 3) {
            if (c + 1 < NCH) { LAS float* bp = hgbuf + ((c + 1) & 1) * (CH * 400);
#pragma unroll
                for (int j = 0; j < 16; ++j) { bp[j * 400 + 128 + pt] = bf2f(rf[j]); bp[j * 400 + 256 + pt] = bf2f(rq[j]); }
#pragma unroll
                for (int j = 0; j < 2; ++j) bp[((pt >> 4) + 8 * j) * 400 + 384 + (pt & 15)] = bf2f(ri[j]);
                if (c + 2 < NCH) HG_LOAD(c + 2); }
            if (c >= 1) {
#pragma unroll
                for (int j = 0; j < 2; ++j) { const int idx = pt + 128 * j; Y[((size_t)hb * TS + (size_t)(c - 1) * CH + (idx >> 4)) * 1536 + 1024 + hh * 128 + vq * 16 + (idx & 15)] = f2bf(hgob[((c - 1) & 1) * 256 + idx]); } }
        } else if (role == 0) {
            if (c >= 0) {
                const LAS float* bp = rwbuf + (c & 1) * (CH * 336) + 8 * ks; LAS float* op = rwob + (c & 1) * 256;
                f32x4 kka = *(const LAS f32x4*)bp, kkb = *(const LAS f32x4*)(bp + 4), wa = *(const LAS f32x4*)(bp + 64), wb = *(const LAS f32x4*)(bp + 68), kaa = *(const LAS f32x4*)(bp + 128), kab = *(const LAS f32x4*)(bp + 132),
                      kpa = *(const LAS f32x4*)(bp + 192), kpb = *(const LAS f32x4*)(bp + 196), ra = *(const LAS f32x4*)(bp + 256), rb4 = *(const LAS f32x4*)(bp + 260);
                float v = bp[320 - 8 * ks + rowi];
#pragma unroll 2
                for (int tt = 0; tt < CH; ++tt) { const LAS float* p = bp + (tt < CH - 1 ? tt + 1 : tt) * 336;
                    const f32x4 nkka = *(const LAS f32x4*)p, nkkb = *(const LAS f32x4*)(p + 4), nwa = *(const LAS f32x4*)(p + 64), nwb = *(const LAS f32x4*)(p + 68), nkaa = *(const LAS f32x4*)(p + 128), nkab = *(const LAS f32x4*)(p + 132),
                                nkpa = *(const LAS f32x4*)(p + 192), nkpb = *(const LAS f32x4*)(p + 196), nra = *(const LAS f32x4*)(p + 256), nrb = *(const LAS f32x4*)(p + 260);
                    const float nv = p[320 - 8 * ks + rowi];
                    const f32x4 d1 = S0 * kka + S1 * kkb; const float sa = grp_sum((d1.x + d1.y) + (d1.z + d1.w));
                    S0 = S0 * wa + (kpa * v - kaa * sa); S1 = S1 * wb + (kpb * v - kab * sa);
                    const f32x4 d2 = S0 * ra + S1 * rb4; const float y = grp_sum((d2.x + d2.y) + (d2.z + d2.w));
                    if (ks == 0) op[tt * 16 + rowi] = y;
                    kka = nkka; kkb = nkkb; wa = nwa; wb = nwb; kaa = nkaa; kab = nkab; kpa = nkpa; kpb = nkpb; ra = nra; rb4 = nrb; v = nv; }
            }
        } else {
            if (c >= 0) {
                const LAS float* bp = hgbuf + (c & 1) * (CH * 400) + 16 * ks; LAS float* op = hgob + (c & 1) * 256;
                f32x4 k0 = *(const LAS f32x4*)(bp + 128), k1 = *(const LAS f32x4*)(bp + 132), k2 = *(const LAS f32x4*)(bp + 136), k3 = *(const LAS f32x4*)(bp + 140);
                f32x4 q0 = *(const LAS f32x4*)(bp + 256), q1 = *(const LAS f32x4*)(bp + 260), q2 = *(const LAS f32x4*)(bp + 264), q3 = *(const LAS f32x4*)(bp + 268);
                float v = bp[384 - 16 * ks + rowi];
#pragma unroll 2
                for (int tt = 0; tt < CH; ++tt) { const LAS float* p = bp + (tt < CH - 1 ? tt + 1 : tt) * 400;
                    const f32x4 nk0 = *(const LAS f32x4*)(p + 128), nk1 = *(const LAS f32x4*)(p + 132), nk2 = *(const LAS f32x4*)(p + 136), nk3 = *(const LAS f32x4*)(p + 140);
                    const f32x4 nq0 = *(const LAS f32x4*)(p + 256), nq1 = *(const LAS f32x4*)(p + 260), nq2 = *(const LAS f32x4*)(p + 264), nq3 = *(const LAS f32x4*)(p + 268);
                    const float nv = p[384 - 16 * ks + rowi];
                    S0 = S0 + k0 * (v - S0); S1 = S1 + k1 * (v - S1); S2 = S2 + k2 * (v - S2); S3 = S3 + k3 * (v - S3);
                    const f32x4 pr = (S0 * q0 + S1 * q1) + (S2 * q2 + S3 * q3); const float o = grp_sum((pr.x + pr.y) + (pr.z + pr.w));
                    if (ks == 0) op[tt * 16 + rowi] = o;
                    k0 = nk0; k1 = nk1; k2 = nk2; k3 = nk3; q0 = nq0; q1 = nq1; q2 = nq2; q3 = nq3; v = nv; }
            }
        }
        __syncthreads();
    }
#undef RW_LOAD
#undef HG_LOAD
    if (role == 2) {
#pragma unroll
        for (int j = 0; j < 2; ++j) { const int idx = pt + 128 * j; YRAW[((size_t)rb * TS + (size_t)(NCH - 1) * CH + (idx >> 4)) * MIXW + rh * 64 + qt * 16 + (idx & 15)] = rwob[((NCH - 1) & 1) * 256 + idx]; } }
    if (role == 3) {
#pragma unroll
        for (int j = 0; j < 2; ++j) { const int idx = pt + 128 * j; Y[((size_t)hb * TS + (size_t)(NCH - 1) * CH + (idx >> 4)) * 1536 + 1024 + hh * 128 + vq * 16 + (idx & 15)] = f2bf(hgob[((NCH - 1) & 1) * 256 + idx]); } }
    __syncthreads();
}
__device__ __forceinline__ void sb_attn_unit(const bf16* QK, const bf16* VT, bf16* Y, int b, int h, int qb, int lane) {
    const int ql = lane & 31, hi = lane >> 5; const int q0 = qb * 32;
    const bf16* qp = QK + ((size_t)(b * TS + q0 + ql) * 1024 + h * 64 + 8 * hi);
    bf16x8 qf[4];
#pragma unroll
    for (int ks = 0; ks < 4; ++ks) qf[ks] = *(const bf16x8*)(qp + 16 * ks);
    const int kperm = 16 * ((ql >> 2) & 1) + 4 * (ql >> 3) + (ql & 3);
    const bf16* kbase = QK + ((size_t)(b * TS + kperm) * 1024 + 512 + h * 64 + 8 * hi);
    const bf16* vbase = VT + ((size_t)((b * 8 + h) * 64 + ql)) * TS + 16 * hi;
    f32x16 o0, o1;
#pragma unroll
    for (int i = 0; i < 16; ++i) { o0[i] = 0.f; o1[i] = 0.f; }
    float carry = 0.f;
    bf16x8 kf[4];
#pragma unroll
    for (int ks = 0; ks < 4; ++ks) kf[ks] = *(const bf16x8*)(kbase + (size_t)q0 * 1024 + 16 * ks);
#pragma unroll 1
    for (int st = qb; st >= 0; --st) {
        const int k0 = st * 32;
        bf16x8 vb[4];
#pragma unroll
        for (int mm = 0; mm < 2; ++mm) { vb[2 * mm] = *(const bf16x8*)(vbase + k0 + 8 * mm); vb[2 * mm + 1] = *(const bf16x8*)(vbase + (size_t)32 * TS + k0 + 8 * mm); }
        f32x16 s;
#pragma unroll
        for (int i = 0; i < 16; ++i) s[i] = 0.f;
#pragma unroll
        for (int ks = 0; ks < 4; ++ks) s = __builtin_amdgcn_mfma_f32_32x32x16_bf16(kf[ks], qf[ks], s, 0, 0, 0);
        if (st > 0) {
#pragma unroll
            for (int ks = 0; ks < 4; ++ks) kf[ks] = *(const bf16x8*)(kbase + (size_t)(k0 - 32) * 1024 + 16 * ks);
        }
        const bool diag = (st == qb);
        float lk[16], zl[16]; float tot = 0.f;
#pragma unroll
        for (int i = 0; i < 16; ++i) { const float z = s[i] * 0.125f; const float sp = fmaxf(z, 0.f) + __logf(1.f + __expf(-fabsf(z)));
            const bool ok = !diag || (16 * hi + i < ql); lk[i] = ok ? -sp : 0.f; zl[i] = ok ? z - sp : -1e30f; tot += lk[i]; }
        const float other = __shfl_xor(tot, 32);
        float run = carry + (hi ? 0.f : other);
        float w[16];
#pragma unroll
        for (int i = 15; i >= 0; --i) { w[i] = __expf(zl[i] + run); run += lk[i]; }
        carry += tot + other;
#pragma unroll
        for (int mm = 0; mm < 2; ++mm) {
            v4u pk; pk.x = pg8::cvt_pk_bf16(w[8 * mm], w[8 * mm + 1]); pk.y = pg8::cvt_pk_bf16(w[8 * mm + 2], w[8 * mm + 3]); pk.z = pg8::cvt_pk_bf16(w[8 * mm + 4], w[8 * mm + 5]); pk.w = pg8::cvt_pk_bf16(w[8 * mm + 6], w[8 * mm + 7]);
            const bf16x8 pa = __builtin_bit_cast(bf16x8, pk);
            o0 = __builtin_amdgcn_mfma_f32_32x32x16_bf16(pa, vb[2 * mm], o0, 0, 0, 0);
            o1 = __builtin_amdgcn_mfma_f32_32x32x16_bf16(pa, vb[2 * mm + 1], o1, 0, 0, 0);
        }
        if (!__any(carry > -80.f)) break;
    }
    bf16* yp = Y + (size_t)(b * TS + q0 + 4 * hi) * 1536 + h * 64 + ql;
#pragma unroll
    for (int i = 0; i < 16; ++i) { const int row = (i & 3) + 8 * (i >> 2); yp[(size_t)row * 1536] = f2bf(o0[i]); yp[(size_t)row * 1536 + 32] = f2bf(o1[i]); }
}
__device__ __forceinline__ void post_mix(const Args& a, int l, int gw, int NGW, int lane) {
    const bf16* PRW = (const bf16*)(a.ws + WS_PRW); const float* YRAW = (const float*)(a.ws + WS_YRAW); const float* BON = (const float*)(a.ws + WS_BON);
    const bf16* LG = (const bf16*)(a.ws + WS_LG); const bf16* HG = (const bf16*)(a.ws + WS_HG); bf16* Y = (bf16*)(a.ws + WS_Y);
    const int c = 8 * lane;
    const float* mu = a.in[4] + (size_t)l * RWIN + 1024 + c; const float* gg = a.in[13] + l * MIXW + c; const float* gb = a.in[14] + l * MIXW + c; const float* ng = a.in[16] + l * MIXW + c;
    const f32x4 mu0 = *(const f32x4*)mu, mu1 = *(const f32x4*)(mu + 4), gg0 = *(const f32x4*)gg, gg1 = *(const f32x4*)(gg + 4), gb0 = *(const f32x4*)gb, gb1 = *(const f32x4*)(gb + 4), ng0 = *(const f32x4*)ng, ng1 = *(const f32x4*)(ng + 4);
    for (int t = gw; t < M; t += NGW) {
        {
            f32x4 y0 = *(const f32x4*)(YRAW + (size_t)t * MIXW + c), y1 = *(const f32x4*)(YRAW + (size_t)t * MIXW + c + 4);
            float s = (y0.x + y0.y) + (y0.z + y0.w) + (y1.x + y1.y) + (y1.z + y1.w); s += __shfl_xor(s, 1); s += __shfl_xor(s, 2); s += __shfl_xor(s, 4);
            const float mean = s * (1.f / 64.f); y0 = y0 - mean; y1 = y1 - mean;
            float q = (y0.x * y0.x + y0.y * y0.y) + (y0.z * y0.z + y0.w * y0.w) + (y1.x * y1.x + y1.y * y1.y) + (y1.z * y1.z + y1.w * y1.w); q += __shfl_xor(q, 1); q += __shfl_xor(q, 2); q += __shfl_xor(q, 4);
            const float rstd = rsqrtf(q * (1.f / 64.f) + GN_EPS);
            f32x4 v0, v1, p0, p1; pg8::unpack8(*(const v4u*)(PRW + (size_t)t * RWIN + 1024 + c), v0, v1);
            if (t & (TS - 1)) pg8::unpack8(*(const v4u*)(PRW + (size_t)(t - 1) * RWIN + 1024 + c), p0, p1); else { p0 = (f32x4){0.f, 0.f, 0.f, 0.f}; p1 = p0; }
            v0 = v0 + (p0 - v0) * mu0; v1 = v1 + (p1 - v1) * mu1;
            const float bon = BON[(size_t)t * 8 + (lane >> 3)];
            f32x4 g0, g1; pg8::unpack8(*(const v4u*)(LG + (size_t)t * MIXW + c), g0, g1);
            const f32x4 r0 = ((y0 * rstd * gg0 + gb0) + v0 * bon) * g0, r1 = ((y1 * rstd * gg1 + gb1) + v1 * bon) * g1;
            *(v4u*)(Y + (size_t)t * 1536 + 512 + c) = pg8::pack8(r0, r1);
        }
        {
            f32x4 o0, o1; pg8::unpack8(*(const v4u*)(Y + (size_t)t * 1536 + 1024 + c), o0, o1);
            float q = (o0.x * o0.x + o0.y * o0.y) + (o0.z * o0.z + o0.w * o0.w) + (o1.x * o1.x + o1.y * o1.y) + (o1.z * o1.z + o1.w * o1.w);
            q += __shfl_xor(q, 1); q += __shfl_xor(q, 2); q += __shfl_xor(q, 4); q += __shfl_xor(q, 8);
            const float rs = rsqrtf(q * (1.f / 128.f) + RMS_EPS);
            f32x4 h0, h1; pg8::unpack8(*(const v4u*)(HG + (size_t)t * 2048 + 1536 + c), h0, h1);
            const f32x4 r0 = o0 * rs * ng0 * h0, r1 = o1 * rs * ng1 * h1;
            *(v4u*)(Y + (size_t)t * 1536 + 1024 + c) = pg8::pack8(r0, r1);
        }
    }
}
#ifndef REP_A
#define REP_A 1
#endif
#ifndef REP_HG
#define REP_HG 1
#endif
#ifndef REP_AT
#define REP_AT 1
#endif
#ifndef REP_B3
#define REP_B3 1
#endif
#ifndef REP_SYNC
#define REP_SYNC 1
#endif
#ifndef REP_LN
#define REP_LN 1
#endif
#ifndef REP_PREP
#define REP_PREP 1
#endif
#ifndef REP_B2
#define REP_B2 1
#endif
#ifndef REP_CDFG
#define REP_CDFG 1
#endif
__global__ void __launch_bounds__(NWAVES * 64, 2) mk_fwd(Args a_unused) {
    extern __shared__ __attribute__((aligned(16))) unsigned char lds_raw[];
    LAS unsigned char* lds = (LAS unsigned char*)lds_raw;
    cg::grid_group grid = cg::this_grid();
    volatile LAS unsigned* bst = (volatile LAS unsigned*)(lds + LDS_BYTES - 64);
    if (threadIdx.x < 2) bst[threadIdx.x] = 0u;
    __syncthreads();
    { typedef const __attribute__((address_space(4))) Args* KA0; KA0 k0 = (KA0)__builtin_amdgcn_kernarg_segment_ptr(); (void)xcd_barrier_post((unsigned*)k0->ws, bst); }
#define GRID_BAR() do { typedef const __attribute__((address_space(4))) Args* KA1; KA1 k1 = (KA1)__builtin_amdgcn_kernarg_segment_ptr(); asm volatile("" : "+s"(k1)); \
        XcdBarrier xb_; xb_.bar = (unsigned*)k1->ws; xb_.x = xb_xcc_id(); xb_.st = bst; xcd_barrier(xb_); } while (0)
    typedef const __attribute__((address_space(4))) Args* KArgs;
#define PHASE_IDS() int tid = threadIdx.x; asm volatile("" : "+v"(tid)); const int lane = tid & 63, wave = __builtin_amdgcn_readfirstlane(tid >> 6); \
    int G = gridDim.x, bid = blockIdx.x; asm volatile("" : "+s"(G), "+s"(bid)); const int gw = bid * NWAVES + wave, NGW = G * NWAVES; \
    KArgs ka = (KArgs)__builtin_amdgcn_kernarg_segment_ptr(); asm volatile("" : "+s"(ka)); const Args a = *(const Args*)ka; unsigned char* ws = a.ws; \
    float* Hf = (float*)(ws + WS_H); bf16* Hb = (bf16*)(ws + WS_HB); float* U = (float*)(ws + WS_U); (void)lane; (void)gw; (void)NGW; (void)Hf; (void)Hb; (void)U; (void)tid

    { PHASE_IDS(); ln_rows(a.in[0], a.in[1], a.in[2], Hf, Hb, gw, NGW, lane);
    conv_weights(a, 0, lds, gw, NGW, wave, lane); }
    grid.sync();

#pragma unroll 1
    for (int l = 0; l < DEPTH; ++l) {
#ifndef SKIP_PA
        { PHASE_IDS();
        { pg8::Gemm g{Hb, (const bf16*)(ws + WS_WIN), M, INC, D, D}; pg8::StaticOrder S; S.init(M, INC, G, bid);
          pg8::Epi1 E{(bf16*)(ws + WS_QK), (bf16*)(ws + WS_VT), (bf16*)(ws + WS_PRW), (bf16*)(ws + WS_HG), (bf16*)(ws + WS_GATE), a.in[15], l};
          for (int rep = 0; rep < REP_A; ++rep) pg8::gemm_phase<pg8::Epi1, pg8::StaticOrder, true, true>(lds, g, S, E); }
        }
#endif
        GRID_BAR();
        for (int rep = 1; rep < REP_SYNC; ++rep) GRID_BAR();
#ifndef SKIP_PB1
        { PHASE_IDS();
        for (int rep = 0; rep < REP_PREP; ++rep) prep_lora_in(a, l, bid * (NWAVES * 64) + tid, G * NWAVES * 64);
        for (int rep = 0; rep < REP_AT; ++rep) for (int wu = gw; wu < 4096; wu += NGW) { const int bh = wu & 63, qb = 63 - (wu >> 6); sb_attn_unit((const bf16*)(ws + WS_QK), (const bf16*)(ws + WS_VT), (bf16*)(ws + WS_Y), bh >> 3, bh & 7, qb, lane); }
        }
#endif
        GRID_BAR();
#ifndef SKIP_PB2
        { PHASE_IDS();
        { int Kl = 256; asm volatile("" : "+s"(Kl));
          pg8::Gemm g{(const bf16*)(ws + WS_T), (const bf16*)(ws + WS_WLORA), M, 1536, Kl, Kl}; pg8::StaticOrder S; S.init(M, 1536, G, bid);
          pg8::EpiLora E{(float*)(ws + WS_LWA), (bf16*)(ws + WS_LG)};
          for (int rep = 0; rep < REP_B2; ++rep) pg8::gemm_phase<pg8::EpiLora, pg8::StaticOrder, true, true>(lds, g, S, E); }
        }
#endif
        GRID_BAR();
#ifndef SKIP_PB2B
        { PHASE_IDS();
        rwkv_prep2(a, l, gw, NGW, lane);
        }
#endif
        GRID_BAR();
#ifndef SKIP_PB3
        { PHASE_IDS();
        for (int rep = 0; rep < REP_B3; ++rep) for (int u = bid; u < 256; u += G) scan_phase(a, l, u, lds, tid);
        }
#endif
        GRID_BAR();
#ifndef SKIP_PB4
        { PHASE_IDS();
        post_mix(a, l, gw, NGW, lane);
        }
#endif
        GRID_BAR();
#ifndef SKIP_PC
        { PHASE_IDS();
        { pg8::Gemm g{(const bf16*)(ws + WS_Y), (const bf16*)(ws + WS_WUP), M, 3072, 512, 1536}; pg8::BranchOrder S{G, bid};
          pg8::Epi2 E{(const bf16*)(ws + WS_GATE), (float*)(ws + WS_MG), (bf16*)(ws + WS_MERGED)};
          for (int rep = 0; rep < REP_CDFG; ++rep) pg8::gemm_phase<pg8::Epi2, pg8::BranchOrder, true, true>(lds, g, S, E); }
        }
#endif
        GRID_BAR();
#ifndef SKIP_PD
        { PHASE_IDS();
        { pg8::Gemm g{(const bf16*)(ws + WS_MERGED), (const bf16*)(ws + WS_WOUT), M, D, D, D}; pg8::StaticOrder S; S.init(M, D, G, bid);
          pg8::Epi3 E{Hf, U, ALPHA};
          for (int rep = 0; rep < REP_CDFG; ++rep) pg8::gemm_phase<pg8::Epi3, pg8::StaticOrder, true, true>(lds, g, S, E); }
        }
#endif
        GRID_BAR();
#ifndef SKIP_PE
        { PHASE_IDS();
        for (int rep = 0; rep < REP_LN; ++rep) ln_rows(U, a.in[19] + l * D, a.in[20] + l * D, Hf, Hb, gw, NGW, lane);
        }
#endif
        GRID_BAR();
#ifndef SKIP_PF
        { PHASE_IDS();
        { pg8::Gemm g{Hb, (const bf16*)(ws + WS_WFI), M, 2 * DFF, D, D}; pg8::StaticOrder S; S.init(M, 2 * DFF, G, bid);
          pg8::Epi4 E{(bf16*)(ws + WS_ACT)};
          for (int rep = 0; rep < REP_CDFG; ++rep) pg8::gemm_phase<pg8::Epi4, pg8::StaticOrder, true, true>(lds, g, S, E); }
        }
#endif
        GRID_BAR();
#ifndef SKIP_PG
        { PHASE_IDS();
        { pg8::Gemm g{(const bf16*)(ws + WS_ACT), (const bf16*)(ws + WS_WFO), M, D, DFF, DFF}; pg8::StaticOrder S; S.init(M, D, G, bid);
          pg8::Epi3 E{Hf, U, ALPHA};
          for (int rep = 0; rep < REP_CDFG; ++rep) pg8::gemm_phase<pg8::Epi3, pg8::StaticOrder, true, true>(lds, g, S, E); }
        }
#endif
        GRID_BAR();
#ifndef SKIP_PH
        { PHASE_IDS();
        if (l + 1 < DEPTH) { for (int rep = 0; rep < REP_LN; ++rep) { ln_rows(U, a.in[23] + l * D, a.in[24] + l * D, Hf, Hb, gw, NGW, lane); conv_weights(a, l + 1, lds, gw, NGW, wave, lane); } GRID_BAR(); }
        else ln_rows(U, a.in[23] + l * D, a.in[24] + l * D, a.out, (bf16*)nullptr, gw, NGW, lane);
        }
#endif
    }
}

extern "C" void kernel_launch(void* const* d_in, const int* in_sizes, int n_in, void* d_out, int out_size, void* d_ws, size_t ws_size, hipStream_t stream) {
    static int grid = 0;
    if (grid == 0) {
        if (n_in != 25 || out_size != M * D || ws_size < WS_END) { fprintf(stderr, "kernel_launch: unexpected shapes (n_in %d, out %d, ws %zu < %zu)\n", n_in, out_size, ws_size, (size_t)WS_END); grid = -1; return; }
        int dev = 0, cus = 0, per_cu = 0;
        hipGetDevice(&dev); hipDeviceGetAttribute(&cus, hipDeviceAttributeMultiprocessorCount, dev);
        if (hipFuncSetAttribute((const void*)mk_fwd, hipFuncAttributeMaxDynamicSharedMemorySize, LDS_BYTES) != hipSuccess) { fprintf(stderr, "kernel_launch: hipFuncSetAttribute failed\n"); grid = -1; return; }
        if (hipOccupancyMaxActiveBlocksPerMultiprocessor(&per_cu, (const void*)mk_fwd, NWAVES * 64, LDS_BYTES) != hipSuccess || per_cu < 1) { fprintf(stderr, "kernel_launch: occupancy query says %d\n", per_cu); per_cu = 1; }
        (void)hipGetLastError();
        grid = cus * 1;
    }
    if (grid < 0) return;
    Args a{};
    for (int i = 0; i < 25; ++i) a.in[i] = (const float*)d_in[i];
    a.out = (float*)d_out; a.ws = (unsigned char*)d_ws;
    if (hipMemsetAsync(d_ws, 0, 16384, stream) != hipSuccess) { fprintf(stderr, "kernel_launch: memset of the barrier words failed\n"); return; }
    void* args[] = {&a};
    hipError_t e = hipLaunchCooperativeKernel((const void*)mk_fwd, dim3(grid), dim3(NWAVES * 64), args, LDS_BYTES, stream);
    if (e != hipSuccess) fprintf(stderr, "kernel_launch: cooperative launch failed: %s (grid %d)\n", hipGetErrorString(e), grid);
}
```
